# Optimizing an MI355X kernel written in HIP

```python
import jax
import jax.numpy as jnp
from jax import lax
import numpy as np

D_MODEL = 1024
BATCH = 16
SEQ = 2048
DEPTH = 2

N_EVEN = (DEPTH + 1) // 2
N_ODD = DEPTH // 2
EPS = 1e-6
NEG_INF = -1e30

SG_HEADS = 4
SG_HEAD_DIM = D_MODEL // 8
SG_WIDTH = SG_HEADS * SG_HEAD_DIM
SG_CHUNK = 128
SC_HEADS = 4
SC_HEAD_DIM = D_MODEL // 8
SC_WIDTH = SC_HEADS * SC_HEAD_DIM
CONV_WIDTH = 3
EVEN_IN = 2 * SG_WIDTH + 3 * SC_WIDTH
EVEN_MIX = SG_WIDTH + SC_WIDTH

POOL_WINDOWS = (2, 4, 8, 16)
POOL_GROUPS = len(POOL_WINDOWS)
POOL_GROUP_DIM = D_MODEL // 16
POOL_WIDTH = POOL_GROUPS * POOL_GROUP_DIM
MLA_HEADS = 6
Q_LORA = 3 * D_MODEL // 8
KV_LORA = D_MODEL // 4
QK_NOPE = 128
QK_ROPE = 64
QK_DIM = QK_NOPE + QK_ROPE
V_DIM = 128
ROPE_THETA = 10000.0
Q_BLOCK = 128
ODD_IN = POOL_WIDTH + Q_LORA + KV_LORA + QK_ROPE
ODD_MIX = POOL_WIDTH + MLA_HEADS * V_DIM

D_FF = ((8 * D_MODEL + 3 * 256 - 1) // (3 * 256)) * 256

kernel_name = 'hybrid_sgu_conv_pool_mla_trunk'


def rms_norm(x, g):
    xf = x.astype(jnp.float32)
    y = xf * lax.rsqrt(jnp.mean(xf * xf, axis=-1, keepdims=True) + EPS)
    return (y * g.astype(jnp.float32)).astype(x.dtype)


def layer_norm(x, g):
    xf = x.astype(jnp.float32)
    mu = jnp.mean(xf, axis=-1, keepdims=True)
    xc = xf - mu
    y = xc * lax.rsqrt(jnp.mean(xc * xc, axis=-1, keepdims=True) + EPS)
    return (y * g.astype(jnp.float32)).astype(x.dtype)


def spatial_gating(u, v, ln_g, w_s, b_s):
    bsz, s, _ = v.shape
    n_chunks = s // SG_CHUNK
    v = layer_norm(v.reshape(bsz, s, SG_HEADS, SG_HEAD_DIM), ln_g.reshape(SG_HEADS, SG_HEAD_DIM))
    v = v.reshape(bsz, n_chunks, SG_CHUNK, SG_HEADS, SG_HEAD_DIM)
    causal = jnp.tril(jnp.ones((SG_CHUNK, SG_CHUNK), dtype=bool))
    w = jnp.where(causal[None], w_s, 0.0).astype(v.dtype)
    mixed = jnp.einsum('hts,bnshd->bnthd', w, v) + b_s.T.astype(v.dtype)[None, None, :, :, None]
    return u * mixed.reshape(bsz, s, SG_WIDTH)


def short_conv(b_gate, c_gate, h, conv_w):
    z = c_gate * h
    y = lax.conv_general_dilated(
        z, conv_w[:, None, :].astype(z.dtype), window_strides=(1,),
        padding=[(CONV_WIDTH - 1, 0)], dimension_numbers=('NWC', 'WIO', 'NWC'),
        feature_group_count=SC_WIDTH)
    return b_gate * y


def multiscale_pool(z, lin_w, scale):
    bsz, s, _ = z.shape
    zf = z.astype(jnp.float32)
    cs = jnp.pad(jnp.cumsum(zf, axis=1), ((0, 0), (1, 0), (0, 0)))
    t = jnp.arange(1, s + 1, dtype=jnp.float32)[None, :, None]
    groups = []
    for g, w in enumerate(POOL_WINDOWS):
        lo, hi = g * POOL_GROUP_DIM, (g + 1) * POOL_GROUP_DIM
        c = cs[..., lo:hi]
        lower = jnp.pad(c[:, :s + 1 - w], ((0, 0), (w - 1, 0), (0, 0)))
        mean = (c[:, 1:] - lower) / jnp.minimum(t, float(w))
        groups.append(mean - zf[..., lo:hi])
    pooled = jnp.stack(groups, axis=2).astype(z.dtype)
    out = jnp.einsum('bsgi,gio->bsgo', pooled, lin_w)
    return out.reshape(bsz, s, POOL_WIDTH) * scale


def rope_tables(positions):
    inv_freq = ROPE_THETA ** (-jnp.arange(0, QK_ROPE, 2, dtype=jnp.float32) / QK_ROPE)
    ang = positions.astype(jnp.float32)[..., None] * inv_freq
    return jnp.cos(ang), jnp.sin(ang)


def apply_rope(x, cos, sin):
    c = cos[:, :, None, :].astype(x.dtype)
    s = sin[:, :, None, :].astype(x.dtype)
    x1, x2 = jnp.split(x, 2, axis=-1)
    return jnp.concatenate([x1 * c - x2 * s, x2 * c + x1 * s], axis=-1)


def latent_attention(q_lat, kv_lat, k_rope, cos, sin, q_a_g, q_b, kv_a_g, kv_b, q_g, k_g):
    bsz, s, _ = q_lat.shape
    q = (rms_norm(q_lat, q_a_g) @ q_b).reshape(bsz, s, MLA_HEADS, QK_DIM)
    kv = (rms_norm(kv_lat, kv_a_g) @ kv_b).reshape(bsz, s, MLA_HEADS, QK_NOPE + V_DIM)
    k_nope, v = kv[..., :QK_NOPE], kv[..., QK_NOPE:]
    k = jnp.concatenate(
        [k_nope, jnp.broadcast_to(k_rope[:, :, None, :], (bsz, s, MLA_HEADS, QK_ROPE))], axis=-1)
    q = rms_norm(q, q_g)
    k = rms_norm(k, k_g)
    q = jnp.concatenate([q[..., :QK_NOPE], apply_rope(q[..., QK_NOPE:], cos, sin)], axis=-1)
    k = jnp.concatenate([k[..., :QK_NOPE], apply_rope(k[..., QK_NOPE:], cos, sin)], axis=-1)
    scale = QK_DIM ** -0.5
    outs = []
    for i in range(s // Q_BLOCK):
        q0, k_end = i * Q_BLOCK, (i + 1) * Q_BLOCK
        logits = jnp.einsum('bqhd,bkhd->bhqk', q[:, q0:k_end], k[:, :k_end]).astype(jnp.float32) * scale
        mask = (q0 + jnp.arange(Q_BLOCK))[:, None] >= jnp.arange(k_end)[None, :]
        p = jax.nn.softmax(jnp.where(mask, logits, NEG_INF), axis=-1).astype(v.dtype)
        outs.append(jnp.einsum('bhqk,bkhd->bqhd', p, v[:, :k_end]))
    return jnp.concatenate(outs, axis=1).reshape(bsz, s, MLA_HEADS * V_DIM)


def swiglu(h, w_gate, w_up, w_down):
    return (jax.nn.silu(h @ w_gate) * (h @ w_up)) @ w_down


def setup_inputs(seed: int = 0) -> dict:
    key = jax.random.key(seed)
    k = jax.random.split(key, 23)
    f32 = jnp.float32

    def nrm(kk, shape, fan_in):
        return jax.random.normal(kk, shape, f32) * (fan_in ** -0.5)

    def gain(kk, shape, noise=0.02):
        return 1.0 + noise * jax.random.normal(kk, shape, f32)

    x = jax.random.normal(k[0], (BATCH, SEQ, D_MODEL), f32)
    positions = (jnp.arange(SEQ, dtype=jnp.int32)[None, :]
                 + jax.random.randint(k[1], (BATCH, 1), 0, SEQ, dtype=jnp.int32))
    return {
        'x': x,
        'positions': positions,
        'mix_norm': gain(k[2], (DEPTH, D_MODEL)),
        'ffn_norm': gain(k[3], (DEPTH, D_MODEL)),
        'even_w_in': nrm(k[4], (N_EVEN, D_MODEL, EVEN_IN), D_MODEL),
        'sg_ln_g': gain(k[5], (N_EVEN, SG_WIDTH)),
        'sg_w_s': nrm(k[6], (N_EVEN, SG_HEADS, SG_CHUNK, SG_CHUNK), SG_CHUNK),
        'sg_b_s': gain(k[7], (N_EVEN, SG_HEADS, SG_CHUNK), 0.1),
        'sc_conv_w': nrm(k[8], (N_EVEN, CONV_WIDTH, SC_WIDTH), CONV_WIDTH),
        'even_w_out': nrm(k[9], (N_EVEN, EVEN_MIX, D_MODEL), EVEN_MIX),
        'odd_w_in': nrm(k[10], (N_ODD, D_MODEL, ODD_IN), D_MODEL),
        'pool_w': nrm(k[11], (N_ODD, POOL_GROUPS, POOL_GROUP_DIM, POOL_GROUP_DIM), POOL_GROUP_DIM),
        'pool_scale': gain(k[12], (N_ODD, POOL_WIDTH), 0.1),
        'q_a_norm': gain(k[13], (N_ODD, Q_LORA)),
        'q_b': nrm(k[14], (N_ODD, Q_LORA, MLA_HEADS * QK_DIM), Q_LORA),
        'kv_a_norm': gain(k[15], (N_ODD, KV_LORA)),
        'kv_b': nrm(k[16], (N_ODD, KV_LORA, MLA_HEADS * (QK_NOPE + V_DIM)), KV_LORA),
        'q_norm': gain(k[17], (N_ODD, QK_DIM)),
        'k_norm': gain(k[18], (N_ODD, QK_DIM)),
        'odd_w_out': nrm(k[19], (N_ODD, ODD_MIX, D_MODEL), ODD_MIX),
        'ffn_w_gate': nrm(k[20], (DEPTH, D_MODEL, D_FF), D_MODEL),
        'ffn_w_up': nrm(k[21], (DEPTH, D_MODEL, D_FF), D_MODEL),
        'ffn_w_down': nrm(k[22], (DEPTH, D_FF, D_MODEL), D_FF),
    }


def reference(x, positions, mix_norm, ffn_norm, even_w_in, sg_ln_g, sg_w_s, sg_b_s, sc_conv_w,
              even_w_out, odd_w_in, pool_w, pool_scale, q_a_norm, q_b, kv_a_norm, kv_b, q_norm,
              k_norm, odd_w_out, ffn_w_gate, ffn_w_up, ffn_w_down):
    cos, sin = rope_tables(positions)
    for layer in range(DEPTH):
        i = layer // 2
        h = rms_norm(x, mix_norm[layer])
        if layer % 2 == 0:
            proj = h @ even_w_in[i]
            u, v, b_gate, c_gate, hv = jnp.split(
                proj, [SG_WIDTH, 2 * SG_WIDTH, 2 * SG_WIDTH + SC_WIDTH, 2 * SG_WIDTH + 2 * SC_WIDTH], axis=-1)
            a_out = spatial_gating(jax.nn.gelu(u, approximate=False), jax.nn.gelu(v, approximate=False),
                                   sg_ln_g[i], sg_w_s[i], sg_b_s[i])
            b_out = short_conv(b_gate, c_gate, hv, sc_conv_w[i])
            x = x + jnp.concatenate([a_out, b_out], axis=-1) @ even_w_out[i]
        else:
            proj = h @ odd_w_in[i]
            z_pool, q_lat, kv_lat, k_rope = jnp.split(
                proj, [POOL_WIDTH, POOL_WIDTH + Q_LORA, POOL_WIDTH + Q_LORA + KV_LORA], axis=-1)
            c_out = multiscale_pool(z_pool, pool_w[i], pool_scale[i])
            d_out = latent_attention(q_lat, kv_lat, k_rope, cos, sin, q_a_norm[i], q_b[i],
                                     kv_a_norm[i], kv_b[i], q_norm[i], k_norm[i])
            x = x + jnp.concatenate([c_out, d_out], axis=-1) @ odd_w_out[i]
        h = rms_norm(x, ffn_norm[layer])
        x = x + swiglu(h, ffn_w_gate[layer], ffn_w_up[layer], ffn_w_down[layer])
    return x
```

```cpp
#include <hip/hip_runtime.h>
#include <hip/hip_cooperative_groups.h>
#include <cstdio>
#include <cstdint>
namespace cg = cooperative_groups;
namespace pg8 {
#define PG8_LAS __attribute__((address_space(3)))
typedef unsigned short bf16_t;
typedef short bf16x8 __attribute__((ext_vector_type(8)));
typedef float f32x4 __attribute__((ext_vector_type(4)));
typedef unsigned u32x4 __attribute__((ext_vector_type(4)));
constexpr int BM = 256, BK = 64, HALF = 128, HTB = HALF * BK * 2  , STAGE_BYTES = 8 * HTB, NXCD = 8, WGM = 8;

__host__ __device__ __forceinline__ int lds_byte(int r, int c) { const int st = (r >> 4) * 2 + (c >> 5), rr = r & 15, cc = c & 31, ob = rr * 64 + cc * 2; return st * 1024 + (ob ^ (((ob >> 9) & 1) << 5)); }
__host__ __device__ __forceinline__ void stage_rc(int b, int& R, int& C) { const int st = b / 1024, sb = b % 1024, swz = sb ^ (((sb >> 9) & 1) << 5); R = (st >> 1) * 16 + swz / 64; C = (st & 1) * 32 + (swz % 64) / 2; }
__host__ __device__ __forceinline__ int perm32(int rho) { const int n = rho >> 4, i = rho & 15; return 8 * (i >> 2) + 4 * n + (i & 3); }

struct Unit { int pm, pn; };
struct Gemm { const bf16_t* A; const bf16_t* Bt; int M, N, K; };

struct StaticOrder {
    int nM, nN, nwg, G, c;
    __host__ __device__ void init(int M, int N, int G_, int c_) { nM = M / BM; nN = N / BM; nwg = nM * nN; G = G_; c = c_; }
    __host__ __device__ bool next(int i, Unit& u) const {
        const long L = (long)i * G + c; if (L >= nwg) return false;
        int wgid = (int)L; { const int q = nwg / NXCD, r = nwg % NXCD, xcd = wgid % NXCD, off = wgid / NXCD; wgid = (xcd < r ? xcd * (q + 1) : r * (q + 1) + (xcd - r) * q) + off; }
        const int nig = WGM * nN, gid = wgid / nig, fm = gid * WGM, gsz = (nM - fm) < WGM ? (nM - fm) : WGM;
        u.pm = fm + ((wgid % nig) % gsz); u.pn = (wgid % nig) / gsz; return true;
    }
    __device__ __forceinline__ void a_ready(const Unit&) const {}
    __device__ __forceinline__ void done(const Unit&) const {}
};

__device__ __forceinline__ unsigned cvt_pk_bf16(float lo, float hi) { unsigned r; asm volatile("v_cvt_pk_bf16_f32 %0, %1, %2" : "=v"(r) : "v"(lo), "v"(hi)); return r; }
typedef float f32x2 __attribute__((ext_vector_type(2)));
__device__ __forceinline__ f32x2 gelu_pk(f32x2 v) {
    const f32x2 av = __builtin_elementwise_abs(v), d = av * 0.2316418882f + 1.0f;
    f32x2 t; t.x = __builtin_amdgcn_rcpf(d.x); t.y = __builtin_amdgcn_rcpf(d.y);
    f32x2 q = t * 0.5307027145f + (-0.7265760135f); q = q * t + 0.7107068705f; q = q * t + (-0.142248368f); q = q * t + 0.127414796f; q = q * t;
    const f32x2 s = (v * v) * (-0.72134752044f);
    f32x2 e; e.x = __builtin_amdgcn_exp2f(s.x); e.y = __builtin_amdgcn_exp2f(s.y);
    const f32x2 m = v * (q * e), r = v - m;
    f32x2 o; o.x = v.x < 0.f ? m.x : r.x; o.y = v.y < 0.f ? m.y : r.y; return o;
}

struct RowScale {
    const PG8_LAS float* tab; const float* ssq; int pm0, pm1, pm2, pm3;
    __device__ __forceinline__ float get(int pm, int rl) const {
        const int slot = pm == pm0 ? 0 : (pm == pm1 ? 1 : (pm == pm2 ? 2 : (pm == pm3 ? 3 : -1)));
        if (slot >= 0) return tab[slot * 256 + rl];
        const f32x4* p = (const f32x4*)(ssq + (size_t)(pm * BM + rl) * 16); const f32x4 a = (p[0] + p[1]) + (p[2] + p[3]);
        return 1.0f / sqrtf(((a[0] + a[1]) + (a[2] + a[3])) * (1.f / 1024.f) + 1e-6f);
    }
};
struct EpiStoreBf16 {
    static constexpr bool PERM = true, AFTER_DRAIN = false;
    bf16_t* O; int ldc; int gelu_cols; int ncols; const float* cscale; bool rowsc; RowScale rsc;
    __device__ __forceinline__ void operator()(const f32x4 (&acc)[2][2][4][2], const Unit& u, int wr, int wc, int fr, int fq) const {
        const int row0 = u.pm * BM + wr * 64 + fr; const int colt = u.pn * BM; const int col0 = colt + wc * 32 + 8 * fq;
        const bool act = colt < gelu_cols;
        f32x4 sv[2][2];
#pragma unroll
        for (int bj = 0; bj < 2; ++bj)
#pragma unroll
            for (int n = 0; n < 2; ++n) sv[bj][n] = (cscale && (col0 + bj * HALF) < ncols) ? *(const f32x4*)(cscale + col0 + bj * HALF + 4 * n) : (f32x4){1.f, 1.f, 1.f, 1.f};
#pragma unroll
        for (int ai = 0; ai < 2; ++ai)
#pragma unroll
            for (int m = 0; m < 4; ++m) { bf16_t* rowp = O + (size_t)(row0 + ai * HALF + m * 16) * ldc + col0;
                const float rs = rowsc ? rsc.get(u.pm, ai * HALF + wr * 64 + m * 16 + fr) : 1.f;
#pragma unroll
                for (int bj = 0; bj < 2; ++bj) { f32x4 v0 = acc[ai][bj][m][0], v1 = acc[ai][bj][m][1];
                    if (act) { f32x2 a = gelu_pk((f32x2){v0[0], v0[1]}), b = gelu_pk((f32x2){v0[2], v0[3]}), c = gelu_pk((f32x2){v1[0], v1[1]}), d = gelu_pk((f32x2){v1[2], v1[3]});
                        v0 = (f32x4){a.x, a.y, b.x, b.y}; v1 = (f32x4){c.x, c.y, d.x, d.y}; }
                    v0 = v0 * sv[bj][0] * rs; v1 = v1 * sv[bj][1] * rs;
                    u32x4 w; w.x = cvt_pk_bf16(v0[0], v0[1]); w.y = cvt_pk_bf16(v0[2], v0[3]); w.z = cvt_pk_bf16(v1[0], v1[1]); w.w = cvt_pk_bf16(v1[2], v1[3]);
                    if (col0 + bj * HALF < ncols) *(u32x4*)(rowp + bj * HALF) = w; } }
    }
};
template <bool BASE_F32, bool OUT_F32, bool SSQW> struct EpiRes {
    static constexpr bool PERM = true, AFTER_DRAIN = false;
    const void* base; void* out; int ldc; float* ssq;
    __device__ __forceinline__ void operator()(const f32x4 (&acc)[2][2][4][2], const Unit& u, int wr, int wc, int fr, int fq) const {
        const int row0 = u.pm * BM + wr * 64 + fr, col0 = u.pn * BM + wc * 32 + 8 * fq;
        const size_t off0 = (size_t)row0 * ldc + col0;
        f32x4 bf[2][2][2][2];
        u32x4 bh[2][2][2];
#define ER_OFF(k, mm, bj) (off0 + (size_t)(((k) >> 1) * HALF + (((k) & 1) * 2 + (mm)) * 16) * ldc + (bj) * HALF)
#define ER_LOAD(k, buf) do { _Pragma("unroll") for (int mm = 0; mm < 2; ++mm) _Pragma("unroll") for (int bj = 0; bj < 2; ++bj) { \
            if constexpr (BASE_F32) { const float* p = (const float*)base + ER_OFF(k, mm, bj); bf[buf][mm][bj][0] = *(const f32x4*)p; bf[buf][mm][bj][1] = *(const f32x4*)(p + 4); } \
            else { bh[buf][mm][bj] = *(const u32x4*)((const bf16_t*)base + ER_OFF(k, mm, bj)); } } } while (0)
#define ER_STORE(k, buf) do { _Pragma("unroll") for (int mm = 0; mm < 2; ++mm) { float sq = 0.f; _Pragma("unroll") for (int bj = 0; bj < 2; ++bj) { f32x4 v0, v1; \
            if constexpr (BASE_F32) { v0 = bf[buf][mm][bj][0]; v1 = bf[buf][mm][bj][1]; } \
            else { const u32x4 q = bh[buf][mm][bj]; v0 = (f32x4){__builtin_bit_cast(float, q.x << 16), __builtin_bit_cast(float, q.x & 0xffff0000u), __builtin_bit_cast(float, q.y << 16), __builtin_bit_cast(float, q.y & 0xffff0000u)}; \
                   v1 = (f32x4){__builtin_bit_cast(float, q.z << 16), __builtin_bit_cast(float, q.z & 0xffff0000u), __builtin_bit_cast(float, q.w << 16), __builtin_bit_cast(float, q.w & 0xffff0000u)}; } \
            v0 = v0 + acc[(k) >> 1][bj][((k) & 1) * 2 + mm][0]; v1 = v1 + acc[(k) >> 1][bj][((k) & 1) * 2 + mm][1]; \
            if constexpr (SSQW) sq += ((v0[0] * v0[0] + v0[1] * v0[1]) + (v0[2] * v0[2] + v0[3] * v0[3])) + ((v1[0] * v1[0] + v1[1] * v1[1]) + (v1[2] * v1[2] + v1[3] * v1[3])); \
            if constexpr (OUT_F32) { float* p = (float*)out + ER_OFF(k, mm, bj); *(f32x4*)p = v0; *(f32x4*)(p + 4) = v1; } \
            else { u32x4 w; w.x = cvt_pk_bf16(v0[0], v0[1]); w.y = cvt_pk_bf16(v0[2], v0[3]); w.z = cvt_pk_bf16(v1[0], v1[1]); w.w = cvt_pk_bf16(v1[2], v1[3]); *(u32x4*)((bf16_t*)out + ER_OFF(k, mm, bj)) = w; } } \
            if constexpr (SSQW) { sq += __shfl_xor(sq, 16); sq += __shfl_xor(sq, 32); if (fq == 0) ssq[(size_t)(row0 + ((k) >> 1) * HALF + (((k) & 1) * 2 + mm) * 16) * 16 + u.pn * 4 + wc] = sq; } } } while (0)
        ER_LOAD(0, 0);
        asm volatile("" ::: "memory");
        ER_LOAD(1, 1);
        asm volatile("" ::: "memory");
        ER_STORE(0, 0);
        asm volatile("" ::: "memory");
        ER_LOAD(2, 0);
        asm volatile("" ::: "memory");
        ER_STORE(1, 1);
        asm volatile("" ::: "memory");
        ER_LOAD(3, 1);
        asm volatile("" ::: "memory");
        ER_STORE(2, 0);
        asm volatile("" ::: "memory");
        ER_STORE(3, 1);
#undef ER_OFF
#undef ER_LOAD
#undef ER_STORE
    }
};
struct EpiSwiGLU {
    static constexpr bool PERM = true, AFTER_DRAIN = false;
    bf16_t* O; int ldc; RowScale rsc;
    __device__ __forceinline__ static float silu_mul(float g, float up) { return g * __builtin_amdgcn_rcpf(1.0f + __expf(-g)) * up; }
    __device__ __forceinline__ void operator()(const f32x4 (&acc)[2][2][4][2], const Unit& u, int wr, int wc, int fr, int fq) const {
        const int row0 = u.pm * BM + wr * 64 + fr, col0 = u.pn * HALF + wc * 32 + 8 * fq;
#pragma unroll
        for (int ai = 0; ai < 2; ++ai)
#pragma unroll
            for (int m = 0; m < 4; ++m) { bf16_t* rowp = O + (size_t)(row0 + ai * HALF + m * 16) * ldc + col0;
                const float rs = rsc.get(u.pm, ai * HALF + wr * 64 + m * 16 + fr);
                const f32x4 g0 = acc[ai][0][m][0] * rs, g1 = acc[ai][0][m][1] * rs, u0 = acc[ai][1][m][0] * rs, u1 = acc[ai][1][m][1] * rs;
                u32x4 w; w.x = cvt_pk_bf16(silu_mul(g0[0], u0[0]), silu_mul(g0[1], u0[1])); w.y = cvt_pk_bf16(silu_mul(g0[2], u0[2]), silu_mul(g0[3], u0[3]));
                w.z = cvt_pk_bf16(silu_mul(g1[0], u1[0]), silu_mul(g1[1], u1[1])); w.w = cvt_pk_bf16(silu_mul(g1[2], u1[2]), silu_mul(g1[3], u1[3]));
                *(u32x4*)rowp = w; }
    }
};

template <class Epi, class Sched, bool ALIGN_EPI = false, bool SP2 = false>
__device__ __forceinline__ void gemm_phase(PG8_LAS unsigned char* lds, const Gemm g, const Sched& S, const Epi& E) {
    const int tid = threadIdx.x, wid = __builtin_amdgcn_readfirstlane(tid >> 6), lane = tid & 63, wr = wid >> 2, wc = wid & 3, fr = lane & 15, fq = lane >> 4;
    const int K = g.K, nt = K / BK;
    unsigned voffA[2], voffB[2];
#pragma unroll
    for (int i = 0; i < 2; ++i) { int R, C; stage_rc(tid * 16 + i * 8192, R, C); const int Rb = Epi::PERM ? ((R & ~31) + perm32(R & 31)) : R;
        voffA[i] = (unsigned)(R * K + C) * 2u; voffB[i] = (unsigned)(Rb * K + C) * 2u; }
    const size_t kstep = (size_t)(BK * 2);
    const size_t hstep = (size_t)HALF * K * 2;
    const size_t tstep = 2 * hstep;
    const unsigned ldsw = (unsigned)wid * 1024u;
    const int aoff = lds_byte(wr * 64 + fr, fq * 8), boff = lds_byte(wc * 32 + fr, fq * 8);
#define PG8_SA(b, h) (((b) * 2 + (h)) * HTB)
#define PG8_SB(b, h) ((4 + (b) * 2 + (h)) * HTB)
#define PG8_STAGE(bufoff, gbase, voff) do { _Pragma("unroll") for (int _i = 0; _i < 2; ++_i) \
        __builtin_amdgcn_global_load_lds((const unsigned*)((const char*)(gbase) + (voff)[_i]), (PG8_LAS unsigned*)(lds + (bufoff) + ldsw + _i * 8192), 16, 0, 0); } while (0)
#define PG8_LDA(dst, b, h) do { _Pragma("unroll") for (int m = 0; m < 4; ++m) _Pragma("unroll") for (int k = 0; k < 2; ++k) dst[m][k] = *(const PG8_LAS bf16x8*)(lds + PG8_SA(b, h) + aoff + m * 2048 + k * 1024); } while (0)
#define PG8_LDB(dst, b, h) do { _Pragma("unroll") for (int n = 0; n < 2; ++n) _Pragma("unroll") for (int k = 0; k < 2; ++k) dst[n][k] = *(const PG8_LAS bf16x8*)(lds + PG8_SB(b, h) + boff + n * 2048 + k * 1024); } while (0)
#define PG8_MMA(ai, bj, At, Bt) do { __builtin_amdgcn_s_setprio(1); _Pragma("unroll") for (int m = 0; m < 4; ++m) _Pragma("unroll") for (int n = 0; n < 2; ++n) _Pragma("unroll") for (int k = 0; k < 2; ++k) \
        acc[ai][bj][m][n] = __builtin_amdgcn_mfma_f32_16x16x32_bf16(Bt[n][k], At[m][k], acc[ai][bj][m][n], 0, 0, 0); __builtin_amdgcn_s_setprio(0); } while (0)
#define PG8_WAIT_V(n) asm volatile("s_waitcnt vmcnt(" #n ")" ::: "memory")
#define PG8_WAIT_L(n) asm volatile("s_waitcnt lgkmcnt(" #n ")" ::: "memory")
#define PG8_BAR __builtin_amdgcn_s_barrier()
#define PG8_SCHED __builtin_amdgcn_sched_barrier(0)
    Unit cur, nxt; int ui = 0;
    if (!S.next(0, cur)) return;
    f32x4 acc[2][2][4][2];
#pragma unroll
    for (int a = 0; a < 2; ++a)
#pragma unroll
        for (int b = 0; b < 2; ++b)
#pragma unroll
            for (int m = 0; m < 4; ++m)
#pragma unroll
                for (int n = 0; n < 2; ++n) acc[a][b][m][n] = (f32x4){0.f, 0.f, 0.f, 0.f};
    bf16x8 At[4][2], B0[2][2], B1[2][2];
    const char* cA = (const char*)g.A + (size_t)cur.pm * tstep; const char* cB = (const char*)g.Bt + (size_t)cur.pn * tstep;
    S.a_ready(cur);
    if constexpr (SP2) {
        PG8_STAGE(PG8_SB(0, 0), cB, voffB); PG8_STAGE(PG8_SB(0, 1), cB + hstep, voffB); PG8_STAGE(PG8_SA(0, 0), cA, voffA); PG8_STAGE(PG8_SA(0, 1), cA + hstep, voffA);
        if (wr == 1) PG8_BAR;
        PG8_WAIT_V(2); PG8_BAR;
        PG8_STAGE(PG8_SB(1, 0), cB + kstep, voffB); PG8_STAGE(PG8_SA(1, 0), cA + kstep, voffA); PG8_STAGE(PG8_SB(1, 1), cB + hstep + kstep, voffB);
        PG8_WAIT_V(6); PG8_BAR;
    } else {
        PG8_STAGE(PG8_SB(0, 0), cB, voffB); PG8_STAGE(PG8_SA(0, 0), cA, voffA); PG8_STAGE(PG8_SB(0, 1), cB + hstep, voffB); PG8_STAGE(PG8_SA(0, 1), cA + hstep, voffA);
        if (wr == 1) PG8_BAR;
        PG8_WAIT_V(4); PG8_BAR;
        PG8_STAGE(PG8_SB(1, 0), cB + kstep, voffB); PG8_STAGE(PG8_SA(1, 0), cA + kstep, voffA); PG8_STAGE(PG8_SB(1, 1), cB + hstep + kstep, voffB);
        PG8_WAIT_V(6); PG8_BAR;
    }
    for (;;) {
        const bool has_next = S.next(ui + 1, nxt);
        const char* nA = has_next ? (const char*)g.A + (size_t)nxt.pm * tstep : cA; const char* nB = has_next ? (const char*)g.Bt + (size_t)nxt.pn * tstep : cB;
        for (int t = 0; t < nt; t += 2) {
            const bool last = (t == nt - 2);
            const char* a1 = cA + (size_t)(t + 1) * kstep;
            const char* a2 = last ? nA : cA + (size_t)(t + 2) * kstep; const char* b2 = last ? nB : cB + (size_t)(t + 2) * kstep;
            const char* a3 = a2 + kstep; const char* b3 = b2 + kstep;
            if (last && has_next) S.a_ready(nxt);
            if constexpr (SP2) {
            PG8_LDB(B0, 0, 0); PG8_LDB(B1, 0, 1); PG8_SCHED; PG8_LDA(At, 0, 0); PG8_STAGE(PG8_SA(1, 1), a1 + hstep, voffA);
            PG8_WAIT_V(8); PG8_WAIT_L(0); PG8_BAR; PG8_MMA(0, 0, At, B0); PG8_MMA(0, 1, At, B1); PG8_BAR; PG8_SCHED;
            PG8_LDA(At, 0, 1); PG8_STAGE(PG8_SB(0, 0), b2, voffB); PG8_STAGE(PG8_SB(0, 1), b2 + hstep, voffB); PG8_STAGE(PG8_SA(0, 0), a2, voffA);
            PG8_WAIT_V(8); PG8_WAIT_L(0); PG8_BAR; PG8_MMA(1, 0, At, B0); PG8_MMA(1, 1, At, B1); PG8_BAR; PG8_SCHED;
            PG8_LDB(B0, 1, 0); PG8_LDB(B1, 1, 1); PG8_SCHED; PG8_LDA(At, 1, 0); PG8_STAGE(PG8_SA(0, 1), a2 + hstep, voffA);
            PG8_WAIT_V(8); PG8_WAIT_L(0); PG8_BAR; PG8_MMA(0, 0, At, B0); PG8_MMA(0, 1, At, B1); PG8_BAR; PG8_SCHED;
            PG8_LDA(At, 1, 1); PG8_STAGE(PG8_SB(1, 0), b3, voffB); PG8_STAGE(PG8_SB(1, 1), b3 + hstep, voffB); PG8_STAGE(PG8_SA(1, 0), a3, voffA);
            PG8_WAIT_V(8); PG8_WAIT_L(0); PG8_BAR; PG8_MMA(1, 0, At, B0); PG8_MMA(1, 1, At, B1); PG8_BAR; PG8_SCHED;
            } else {
            PG8_LDB(B0, 0, 0); PG8_SCHED; PG8_LDA(At, 0, 0); PG8_STAGE(PG8_SA(1, 1), a1 + hstep, voffA);
            PG8_WAIT_L(8); PG8_BAR; PG8_WAIT_L(0); PG8_MMA(0, 0, At, B0); PG8_BAR; PG8_SCHED;
            PG8_LDB(B1, 0, 1); PG8_STAGE(PG8_SB(0, 0), b2, voffB);
            PG8_BAR; PG8_WAIT_L(0); PG8_MMA(0, 1, At, B1); PG8_BAR;
            PG8_LDA(At, 0, 1); PG8_STAGE(PG8_SA(0, 0), a2, voffA);
            PG8_BAR; PG8_WAIT_L(0); PG8_MMA(1, 0, At, B0); PG8_BAR; PG8_SCHED;
            PG8_STAGE(PG8_SB(0, 1), b2 + hstep, voffB);
            PG8_WAIT_V(6); PG8_BAR; PG8_MMA(1, 1, At, B1); PG8_BAR;
            PG8_LDB(B0, 1, 0); PG8_SCHED; PG8_LDA(At, 1, 0); PG8_STAGE(PG8_SA(0, 1), a2 + hstep, voffA);
            PG8_WAIT_L(8); PG8_BAR; PG8_WAIT_L(0); PG8_MMA(0, 0, At, B0); PG8_BAR; PG8_SCHED;
            PG8_LDB(B1, 1, 1); PG8_STAGE(PG8_SB(1, 0), b3, voffB);
            PG8_BAR; PG8_WAIT_L(0); PG8_MMA(0, 1, At, B1); PG8_BAR;
            PG8_LDA(At, 1, 1); PG8_STAGE(PG8_SA(1, 0), a3, voffA);
            PG8_BAR; PG8_WAIT_L(0); PG8_MMA(1, 0, At, B0); PG8_BAR; PG8_SCHED;
            PG8_STAGE(PG8_SB(1, 1), b3 + hstep, voffB);
            PG8_WAIT_V(6); PG8_BAR; PG8_MMA(1, 1, At, B1); PG8_BAR;
            }
        }
        if constexpr (ALIGN_EPI) { if (wr == 0) PG8_BAR; }
        if constexpr (!Epi::AFTER_DRAIN) { E(acc, cur, wr, wc, fr, fq); S.done(cur); }
        if (!has_next) break;
#pragma unroll
        for (int a = 0; a < 2; ++a)
#pragma unroll
            for (int b = 0; b < 2; ++b)
#pragma unroll
                for (int m = 0; m < 4; ++m)
#pragma unroll
                    for (int n = 0; n < 2; ++n) acc[a][b][m][n] = (f32x4){0.f, 0.f, 0.f, 0.f};
        cur = nxt; cA = nA; cB = nB; ++ui;
        if constexpr (ALIGN_EPI) { if (wr == 1) PG8_BAR; }
    }
    PG8_WAIT_V(0);
    if constexpr (!ALIGN_EPI) { if (wr == 0) PG8_BAR; }
    PG8_BAR;
    if constexpr (Epi::AFTER_DRAIN) { E.fused(acc, cur, wr, wc, fr, fq, lds, wid, lane); S.done(cur); }
#undef PG8_SA
#undef PG8_SB
#undef PG8_STAGE
#undef PG8_LDA
#undef PG8_LDB
#undef PG8_MMA
#undef PG8_WAIT_V
#undef PG8_WAIT_L
#undef PG8_BAR
#undef PG8_SCHED
}
}

constexpr int NWAVES = 8, NTHR = 512;
constexpr int BATCH = 16, SEQ = 2048, D = 1024, M = BATCH * SEQ;
constexpr int EVEN_IN = 2560, DFF = 2816, NGU = 2 * DFF;
constexpr int ODD_IN = 960, ODD_IN_P = 1024, POOLW = 256, QLORA = 384, KVLORA = 256;
constexpr int NH = 6, QKD = 192, NQ = NH * QKD  , NQ_P = 1280, NKV = NH * 256  ;
constexpr float EPS = 1e-6f;
constexpr float QSCALE = 0.07216878364870322f * 1.4426950408889634f;

constexpr size_t MiB = 1u << 20;
constexpr int XCD_BAR_WORDS_C = 3456;
constexpr size_t WS_WIN0 = 1 * MiB;
constexpr size_t WS_WOUT0 = WS_WIN0 + (size_t)EVEN_IN * D * 2;
constexpr size_t WS_WGU = WS_WOUT0 + (size_t)D * D * 2;
constexpr size_t WS_WDN = WS_WGU + 2 * (size_t)NGU * D * 2;
constexpr size_t WS_WIN1 = WS_WDN + 2 * (size_t)D * DFF * 2;
constexpr size_t WS_WQB = WS_WIN1 + (size_t)ODD_IN_P * D * 2;
constexpr size_t WS_WKVB = WS_WQB + (size_t)NQ_P * QLORA * 2;
constexpr size_t WS_WPOOL = WS_WKVB + (size_t)NKV * KVLORA * 2;
constexpr size_t WS_WOUT1 = WS_WPOOL + (size_t)POOLW * POOLW * 2;
constexpr size_t WS_COS = WS_WOUT1 + (size_t)D * D * 2;
constexpr size_t WS_SIN = WS_COS + (size_t)M * 32 * 4;
constexpr size_t WS_WEND = WS_SIN + (size_t)M * 32 * 4;
static_assert(XCD_BAR_WORDS_C * 4 <= 16384 && WS_WEND <= 56 * MiB, "weights region");
constexpr size_t WS_MIX = 56 * MiB;
constexpr size_t WS_XN = 120 * MiB;
constexpr size_t WS_R = 184 * MiB;
constexpr size_t WS_PROJ0 = WS_R;
constexpr size_t WS_ACT = WS_R;
constexpr size_t WS_PROJ1 = WS_R;
constexpr size_t WS_QN = WS_R + 64 * MiB;
constexpr size_t WS_KVN = WS_R + 88 * MiB;
constexpr size_t WS_POOLED = WS_R + 104 * MiB;
constexpr size_t WS_KROPE = WS_R + 120 * MiB;
constexpr size_t WS_QRAW = WS_R + 124 * MiB;
constexpr size_t WS_XB = WS_R + 196 * MiB;
constexpr size_t WS_KB = WS_XN;
constexpr size_t WS_VT = 192 * MiB;
constexpr size_t WS_SSQ = WS_XB + 64 * MiB;
constexpr size_t WS_END = WS_SSQ + 2 * MiB;
static_assert(WS_END <= 512 * MiB, "d_ws map");

constexpr int RSTAB_OFF = 131072 + 64;
constexpr int LDS_BYTES = 136192;

#define LAS __attribute__((address_space(3)))
typedef unsigned short bf16;
typedef unsigned v4u __attribute__((ext_vector_type(4)));
typedef unsigned v2u __attribute__((ext_vector_type(2)));
typedef float f32x4 __attribute__((ext_vector_type(4)));
typedef float f32x16 __attribute__((ext_vector_type(16)));
typedef short bf16x8 __attribute__((ext_vector_type(8)));
typedef short s16x4 __attribute__((ext_vector_type(4)));
#define LDS_WAIT() asm volatile("s_waitcnt lgkmcnt(0)" ::: "memory")
__device__ __forceinline__ unsigned f2bf(float f) { unsigned u = __builtin_bit_cast(unsigned, f); return (u + 0x7fffu + ((u >> 16) & 1u)) >> 16; }
__device__ __forceinline__ unsigned pk2(float lo, float hi) { return pg8::cvt_pk_bf16(lo, hi); }
__device__ __forceinline__ float bflo(unsigned w) { return __builtin_bit_cast(float, w << 16); }
__device__ __forceinline__ float bfhi(unsigned w) { return __builtin_bit_cast(float, w & 0xffff0000u); }
__device__ __forceinline__ float wave_sum(float v) {
#pragma unroll
    for (int o = 1; o < 64; o <<= 1) v += __shfl_xor(v, o);
    return v;
}

struct Frame {
    LAS unsigned char* lds;
    int tid, lane, wave, G, bid;
};

__device__ __forceinline__ void tr_item(const float* W, int ldn, int k0, int n0, bf16* WT, int ldk, int drow0, int dk0, LAS float* scr, int lane, const float* gk = nullptr) {
#pragma unroll 8
    for (int i = 0; i < 32; ++i) { const int kk = 2 * i + (lane >> 5); scr[kk * 33 + (lane & 31)] = W[(size_t)(k0 + kk) * ldn + n0 + (lane & 31)] * (gk ? gk[k0 + kk] : 1.f); }
    LDS_WAIT(); asm volatile("" ::: "memory");
    const int c = lane & 7;
#pragma unroll
    for (int j = 0; j < 4; ++j) { const int n = (lane >> 3) + 8 * j; const LAS float* s = scr + (8 * c) * 33 + n;
        v4u o; o.x = pk2(s[0 * 33], s[1 * 33]); o.y = pk2(s[2 * 33], s[3 * 33]); o.z = pk2(s[4 * 33], s[5 * 33]); o.w = pk2(s[6 * 33], s[7 * 33]);
        *(v4u*)(WT + (size_t)(drow0 + n) * ldk + dk0 + 8 * c) = o; }
    LDS_WAIT(); asm volatile("" ::: "memory");
}
template <int MODE> __device__ __forceinline__ void tr_matrix(const Frame& F, const float* W, int K, int N, bf16* WT, LAS float* scr, const float* gk = nullptr) {
    const int nnb = N / 32, nit = (K / 64) * nnb; const int gw = F.bid * NWAVES + F.wave, NGW = F.G * NWAVES;
    for (int it = gw; it < nit; it += NGW) { const int kb = it / nnb, nb = it % nnb, n0 = 32 * nb;
        const int dr = MODE == 0 ? n0 : (256 * (n0 >> 7) + (n0 & 127) + (MODE == 2 ? 128 : 0));
        tr_item(W, N, 64 * kb, n0, WT, K, dr, 64 * kb, scr, F.lane, gk); }
}
template <bool IN_F32> __device__ __forceinline__ void rms_rows(const Frame& F, const void* Xv, const float* g, bf16* XN) {
    const int gw = F.bid * NWAVES + F.wave, NGW = F.G * NWAVES;
    f32x4 gv[4];
#pragma unroll
    for (int j = 0; j < 4; ++j) gv[j] = ((const f32x4*)g)[F.lane + 64 * j];
    for (int m = gw; m < M; m += NGW) {
        f32x4 v[4]; float s = 0.f;
        if constexpr (IN_F32) { const f32x4* xr = (const f32x4*)((const float*)Xv + (size_t)m * D) + F.lane;
#pragma unroll
            for (int j = 0; j < 4; ++j) v[j] = xr[64 * j]; }
        else { const v2u* xr = (const v2u*)((const bf16*)Xv + (size_t)m * D) + F.lane;
#pragma unroll
            for (int j = 0; j < 4; ++j) { const v2u q = xr[64 * j]; v[j] = (f32x4){bflo(q.x), bfhi(q.x), bflo(q.y), bfhi(q.y)}; } }
#pragma unroll
        for (int j = 0; j < 4; ++j) s += (v[j].x * v[j].x + v[j].y * v[j].y) + (v[j].z * v[j].z + v[j].w * v[j].w);
        const float rstd = 1.0f / sqrtf(wave_sum(s) * (1.f / D) + EPS);
        unsigned long long* o8 = (unsigned long long*)(XN + (size_t)m * D) + F.lane;
#pragma unroll
        for (int j = 0; j < 4; ++j) { const f32x4 y = v[j] * rstd * gv[j]; o8[64 * j] = (unsigned long long)pk2(y.x, y.y) | ((unsigned long long)pk2(y.z, y.w) << 32); }
    }
}
struct Ptrs {
    const float* in[23]; const int* pos; float* out; unsigned char* ws;
};
__device__ __forceinline__ void p0_prologue(const Frame& F, const Ptrs& P) {
    LAS float* scr = (LAS float*)(F.lds + F.wave * 16384);
    unsigned char* ws = P.ws;
    tr_matrix<0>(F, P.in[4], D, EVEN_IN, (bf16*)(ws + WS_WIN0), scr);
    tr_matrix<0>(F, P.in[9], D, D, (bf16*)(ws + WS_WOUT0), scr);
    for (int l = 0; l < 2; ++l) {
        tr_matrix<1>(F, P.in[20] + (size_t)l * D * DFF, D, DFF, (bf16*)(ws + WS_WGU) + (size_t)l * NGU * D, scr, P.in[3] + l * D);
        tr_matrix<2>(F, P.in[21] + (size_t)l * D * DFF, D, DFF, (bf16*)(ws + WS_WGU) + (size_t)l * NGU * D, scr, P.in[3] + l * D);
        tr_matrix<0>(F, P.in[22] + (size_t)l * DFF * D, DFF, D, (bf16*)(ws + WS_WDN) + (size_t)l * D * DFF, scr);
    }
    tr_matrix<0>(F, P.in[10], D, ODD_IN, (bf16*)(ws + WS_WIN1), scr, P.in[2] + D);
    tr_matrix<0>(F, P.in[14], QLORA, NQ, (bf16*)(ws + WS_WQB), scr);
    tr_matrix<0>(F, P.in[16], KVLORA, NKV, (bf16*)(ws + WS_WKVB), scr);
    tr_matrix<0>(F, P.in[19], D, D, (bf16*)(ws + WS_WOUT1), scr);
    const int gw = F.bid * NWAVES + F.wave, NGW = F.G * NWAVES;
    for (int it = gw; it < 8; it += NGW) { const int g = it >> 1, nb = it & 1;
        tr_item(P.in[11] + g * 4096, 64, 0, 32 * nb, (bf16*)(ws + WS_WPOOL), POOLW, g * 64 + 32 * nb, g * 64, scr, F.lane); }
    const int gt = F.bid * NTHR + F.tid, NGT = F.G * NTHR;
    const v4u z4 = {0u, 0u, 0u, 0u};
    { v4u* p = (v4u*)((bf16*)(ws + WS_WIN1) + (size_t)ODD_IN * D); for (int i = gt; i < (ODD_IN_P - ODD_IN) * D / 8; i += NGT) p[i] = z4; }
    { v4u* p = (v4u*)((bf16*)(ws + WS_WQB) + (size_t)NQ * QLORA); for (int i = gt; i < (NQ_P - NQ) * QLORA / 8; i += NGT) p[i] = z4; }
    { v4u* p = (v4u*)(ws + WS_WPOOL); for (int i = gt; i < POOLW * POOLW / 8; i += NGT) { const int row = i >> 5, kblk = (i & 31) >> 3; if (kblk != (row >> 6)) p[i] = z4; } }
    { float* C = (float*)(ws + WS_COS); float* S = (float*)(ws + WS_SIN);
      for (int i = gt; i < M * 32; i += NGT) { const int m = i >> 5, f = i & 31;
          const float inv = powf(10000.0f, -(float)(2 * f) / 64.0f); const float ang = (float)P.pos[m] * inv;
          const double rev = (double)ang * 0.15915494309189535; const float fr = (float)(rev - rint(rev));
          C[i] = __builtin_amdgcn_cosf(fr); S[i] = __builtin_amdgcn_sinf(fr); } }
    rms_rows<true>(F, P.in[0], P.in[2], (bf16*)(ws + WS_XN));
}

__device__ __forceinline__ void p2_even_mixer(const Frame& F, const Ptrs& P) {
    constexpr int PITCH = 136;
    LAS bf16* sW = (LAS bf16*)(F.lds);
    LAS bf16* sV = (LAS bf16*)(F.lds + 128 * PITCH * 2);
    const bf16* PROJ = (const bf16*)(P.ws + WS_PROJ0); bf16* MIX = (bf16*)(P.ws + WS_MIX);
    const float* ln_g = P.in[5]; const float* w_s = P.in[6]; const float* b_s = P.in[7]; const float* conv_w = P.in[8];
    const int tid = F.tid, lane = F.lane, w = F.wave;
    int hcur = -1;
    for (int u = F.bid; u < 1536; u += F.G) {
        if (u < 1024) {
            const int b = u >> 6, n = (u >> 2) & 15, h = u & 3; const int tok0 = b * SEQ + n * 128;
            v2u uqv[8];
            { const size_t tokl = (size_t)(tok0 + 16 * w + (lane & 15));
#pragma unroll
              for (int dt = 0; dt < 8; ++dt) uqv[dt] = *(const v2u*)(PROJ + tokl * EVEN_IN + h * 128 + 16 * dt + 4 * (lane >> 4)); }
            if (h != hcur) {
                hcur = h;
                const int t = tid >> 2, s0 = (tid & 3) * 32; const f32x4* src = (const f32x4*)(w_s + ((size_t)h * 128 + t) * 128 + s0);
#pragma unroll
                for (int i = 0; i < 4; ++i) { f32x4 a = src[2 * i], c = src[2 * i + 1]; const int s = s0 + 8 * i;
                    v4u o; o.x = pk2(s + 0 <= t ? a.x : 0.f, s + 1 <= t ? a.y : 0.f); o.y = pk2(s + 2 <= t ? a.z : 0.f, s + 3 <= t ? a.w : 0.f);
                    o.z = pk2(s + 4 <= t ? c.x : 0.f, s + 5 <= t ? c.y : 0.f); o.w = pk2(s + 6 <= t ? c.z : 0.f, s + 7 <= t ? c.w : 0.f);
                    *(LAS v4u*)(sW + t * PITCH + s) = o; }
            }
            {
                const int s = tid >> 2, d0 = (tid & 3) * 32; const v4u* src = (const v4u*)(PROJ + (size_t)(tok0 + s) * EVEN_IN + 512 + h * 128 + d0);
                float v[32]; float sum = 0.f;
#pragma unroll
                for (int i = 0; i < 4; ++i) { const v4u q = src[i];
                    v[8 * i + 0] = bflo(q.x); v[8 * i + 1] = bfhi(q.x); v[8 * i + 2] = bflo(q.y); v[8 * i + 3] = bfhi(q.y);
                    v[8 * i + 4] = bflo(q.z); v[8 * i + 5] = bfhi(q.z); v[8 * i + 6] = bflo(q.w); v[8 * i + 7] = bfhi(q.w); }
#pragma unroll
                for (int i = 0; i < 32; ++i) sum += v[i];
                sum += __shfl_xor(sum, 1); sum += __shfl_xor(sum, 2);
                const float mean = sum * (1.f / 128.f); float sq = 0.f;
#pragma unroll
                for (int i = 0; i < 32; ++i) { v[i] -= mean; sq += v[i] * v[i]; }
                sq += __shfl_xor(sq, 1); sq += __shfl_xor(sq, 2);
                const float rstd = 1.0f / sqrtf(sq * (1.f / 128.f) + EPS);
                const f32x4* gp = (const f32x4*)(ln_g + h * 128 + d0);
#pragma unroll
                for (int i = 0; i < 8; ++i) { const f32x4 g = gp[i];
                    sV[(d0 + 4 * i + 0) * PITCH + s] = (bf16)f2bf(v[4 * i + 0] * rstd * g.x); sV[(d0 + 4 * i + 1) * PITCH + s] = (bf16)f2bf(v[4 * i + 1] * rstd * g.y);
                    sV[(d0 + 4 * i + 2) * PITCH + s] = (bf16)f2bf(v[4 * i + 2] * rstd * g.z); sV[(d0 + 4 * i + 3) * PITCH + s] = (bf16)f2bf(v[4 * i + 3] * rstd * g.w); }
            }
            __syncthreads();
            f32x4 acc[8];
#pragma unroll
            for (int dt = 0; dt < 8; ++dt) acc[dt] = (f32x4){0.f, 0.f, 0.f, 0.f};
            const int nk = (w >> 1) + 1;
            for (int ks = 0; ks < nk; ++ks) {
                const bf16x8 bw = *(const LAS bf16x8*)(sW + (16 * w + (lane & 15)) * PITCH + ks * 32 + (lane >> 4) * 8);
#pragma unroll
                for (int dt = 0; dt < 8; ++dt) { const bf16x8 av = *(const LAS bf16x8*)(sV + (16 * dt + (lane & 15)) * PITCH + ks * 32 + (lane >> 4) * 8);
                    acc[dt] = __builtin_amdgcn_mfma_f32_16x16x32_bf16(av, bw, acc[dt], 0, 0, 0); }
            }
            { const int t = 16 * w + (lane & 15); const float bias = b_s[h * 128 + t]; const size_t tok = (size_t)(tok0 + t);
#pragma unroll
              for (int dt = 0; dt < 8; ++dt) { const int d0 = 16 * dt + 4 * (lane >> 4);
                  const v2u uq = uqv[dt];
                  v2u o; o.x = pk2(bflo(uq.x) * (acc[dt][0] + bias), bfhi(uq.x) * (acc[dt][1] + bias)); o.y = pk2(bflo(uq.y) * (acc[dt][2] + bias), bfhi(uq.y) * (acc[dt][3] + bias));
                  *(v2u*)(MIX + tok * D + h * 128 + d0) = o; } }
            __syncthreads();
        } else {
            const int cu = u - 1024, c0 = (tid & 63) * 8, tg = tid >> 6; const int tokb = cu * 64 + tg * 8; const int sb = tokb & (SEQ - 1);
            float w0[8], w1[8], w2[8];
#pragma unroll
            for (int e = 0; e < 2; ++e) { const f32x4 a = *(const f32x4*)(conv_w + c0 + 4 * e), c = *(const f32x4*)(conv_w + 512 + c0 + 4 * e), d = *(const f32x4*)(conv_w + 1024 + c0 + 4 * e);
#pragma unroll
                for (int k = 0; k < 4; ++k) { w0[4 * e + k] = a[k]; w1[4 * e + k] = c[k]; w2[4 * e + k] = d[k]; } }
            float zp2[8], zp1[8];
#pragma unroll
            for (int k = 0; k < 8; ++k) { zp2[k] = 0.f; zp1[k] = 0.f; }
#pragma unroll
            for (int i = -2; i < 8; ++i) {
                if (i < 0 && sb + i < 0) continue;
                const bf16* row = PROJ + (size_t)(tokb + i) * EVEN_IN;
                const v4u cq = *(const v4u*)(row + 1536 + c0), hq = *(const v4u*)(row + 2048 + c0);
                float z[8];
                z[0] = bflo(cq.x) * bflo(hq.x); z[1] = bfhi(cq.x) * bfhi(hq.x); z[2] = bflo(cq.y) * bflo(hq.y); z[3] = bfhi(cq.y) * bfhi(hq.y);
                z[4] = bflo(cq.z) * bflo(hq.z); z[5] = bfhi(cq.z) * bfhi(hq.z); z[6] = bflo(cq.w) * bflo(hq.w); z[7] = bfhi(cq.w) * bfhi(hq.w);
                if (i >= 0) { const v4u bq = *(const v4u*)(row + 1024 + c0);
                    float bg[8]; bg[0] = bflo(bq.x); bg[1] = bfhi(bq.x); bg[2] = bflo(bq.y); bg[3] = bfhi(bq.y); bg[4] = bflo(bq.z); bg[5] = bfhi(bq.z); bg[6] = bflo(bq.w); bg[7] = bfhi(bq.w);
                    float y[8];
#pragma unroll
                    for (int k = 0; k < 8; ++k) y[k] = bg[k] * (w0[k] * zp2[k] + w1[k] * zp1[k] + w2[k] * z[k]);
                    v4u o; o.x = pk2(y[0], y[1]); o.y = pk2(y[2], y[3]); o.z = pk2(y[4], y[5]); o.w = pk2(y[6], y[7]);
                    *(v4u*)(MIX + (size_t)(tokb + i) * D + 512 + c0) = o; }
#pragma unroll
                for (int k = 0; k < 8; ++k) { zp2[k] = zp1[k]; zp1[k] = z[k]; }
            }
        }
    }
}

__device__ __forceinline__ void p9_token_ops(const Frame& F, const Ptrs& P) {
    const bf16* PROJ = (const bf16*)(P.ws + WS_PROJ1);
    bf16* QN = (bf16*)(P.ws + WS_QN); bf16* KVN = (bf16*)(P.ws + WS_KVN); bf16* PL = (bf16*)(P.ws + WS_POOLED); bf16* KR = (bf16*)(P.ws + WS_KROPE);
    const int lane = F.lane; const int gw = F.bid * NWAVES + F.wave, NGW = F.G * NWAVES;
    const int j16 = lane & 15;
    f32x4 gqv[6], gkvv[4];
#pragma unroll
    for (int k = 0; k < 6; ++k) gqv[k] = *(const f32x4*)(P.in[13] + 24 * j16 + 4 * k);
#pragma unroll
    for (int k = 0; k < 4; ++k) gkvv[k] = *(const f32x4*)(P.in[15] + 16 * j16 + 4 * k);
    const int lg = lane >> 4;
    for (int grp = gw; grp < M / 16; grp += NGW) {
        const int m0 = grp * 16; const int s0 = m0 & (SEQ - 1);
        v2u hq[31];
#pragma unroll
        for (int i = 0; i < 31; ++i) { if (i >= 15 || s0 != 0) hq[i] = *(const v2u*)(PROJ + (size_t)(m0 + i - 15) * ODD_IN_P + 4 * lane); else hq[i] = (v2u){0u, 0u}; }
#pragma unroll 2
        for (int r4 = 0; r4 < 4; ++r4) {
            const int m = m0 + 4 * r4 + (lane >> 4); const bf16* row = PROJ + (size_t)m * ODD_IN_P;
            v4u qv[3], kvv[2];
#pragma unroll
            for (int k = 0; k < 3; ++k) qv[k] = *(const v4u*)(row + 256 + 24 * j16 + 8 * k);
#pragma unroll
            for (int k = 0; k < 2; ++k) kvv[k] = *(const v4u*)(row + 640 + 16 * j16 + 8 * k);
            v4u krv = {0u, 0u, 0u, 0u}; if (j16 < 8) krv = *(const v4u*)(row + 896 + 8 * j16);
            float sq = 0.f, sk = 0.f;
#pragma unroll
            for (int k = 0; k < 3; ++k) { const v4u q = qv[k]; const float a0 = bflo(q.x), a1 = bfhi(q.x), a2 = bflo(q.y), a3 = bfhi(q.y), a4 = bflo(q.z), a5 = bfhi(q.z), a6 = bflo(q.w), a7 = bfhi(q.w);
                sq += ((a0 * a0 + a1 * a1) + (a2 * a2 + a3 * a3)) + ((a4 * a4 + a5 * a5) + (a6 * a6 + a7 * a7)); }
#pragma unroll
            for (int k = 0; k < 2; ++k) { const v4u q = kvv[k]; const float a0 = bflo(q.x), a1 = bfhi(q.x), a2 = bflo(q.y), a3 = bfhi(q.y), a4 = bflo(q.z), a5 = bfhi(q.z), a6 = bflo(q.w), a7 = bfhi(q.w);
                sk += ((a0 * a0 + a1 * a1) + (a2 * a2 + a3 * a3)) + ((a4 * a4 + a5 * a5) + (a6 * a6 + a7 * a7)); }
#pragma unroll
            for (int o = 1; o < 16; o <<= 1) { sq += __shfl_xor(sq, o); sk += __shfl_xor(sk, o); }
            const float rq = 1.0f / sqrtf(sq * (1.f / QLORA) + EPS), rk = 1.0f / sqrtf(sk * (1.f / KVLORA) + EPS);
#pragma unroll
            for (int k = 0; k < 3; ++k) { const v4u q = qv[k]; const f32x4 ga = gqv[2 * k], gb = gqv[2 * k + 1];
                v4u o; o.x = pk2(bflo(q.x) * rq * ga.x, bfhi(q.x) * rq * ga.y); o.y = pk2(bflo(q.y) * rq * ga.z, bfhi(q.y) * rq * ga.w);
                o.z = pk2(bflo(q.z) * rq * gb.x, bfhi(q.z) * rq * gb.y); o.w = pk2(bflo(q.w) * rq * gb.z, bfhi(q.w) * rq * gb.w);
                *(v4u*)(QN + (size_t)m * QLORA + 24 * j16 + 8 * k) = o; }
#pragma unroll
            for (int k = 0; k < 2; ++k) { const v4u q = kvv[k]; const f32x4 ga = gkvv[2 * k], gb = gkvv[2 * k + 1];
                v4u o; o.x = pk2(bflo(q.x) * rk * ga.x, bfhi(q.x) * rk * ga.y); o.y = pk2(bflo(q.y) * rk * ga.z, bfhi(q.y) * rk * ga.w);
                o.z = pk2(bflo(q.z) * rk * gb.x, bfhi(q.z) * rk * gb.y); o.w = pk2(bflo(q.w) * rk * gb.z, bfhi(q.w) * rk * gb.w);
                *(v4u*)(KVN + (size_t)m * KVLORA + 16 * j16 + 8 * k) = o; }
            if (j16 < 8) *(v4u*)(KR + (size_t)m * 64 + 8 * j16) = krv;
        }
        f32x4 hst[31];
#pragma unroll
        for (int i = 0; i < 31; ++i) hst[i] = (f32x4){bflo(hq[i].x), bfhi(hq[i].x), bflo(hq[i].y), bfhi(hq[i].y)};
#pragma unroll
        for (int r = 0; r < 16; ++r) {
            const f32x4 s2 = hst[15 + r] + hst[14 + r];
            const f32x4 s4 = s2 + (hst[13 + r] + hst[12 + r]);
            const f32x4 s8 = s4 + ((hst[11 + r] + hst[10 + r]) + (hst[9 + r] + hst[8 + r]));
            const f32x4 s16 = s8 + (((hst[7 + r] + hst[6 + r]) + (hst[5 + r] + hst[4 + r])) + ((hst[3 + r] + hst[2 + r]) + (hst[1 + r] + hst[r])));
            const f32x4 sw = lg == 0 ? s2 : (lg == 1 ? s4 : (lg == 2 ? s8 : s16));
            const int cnt = min(s0 + r + 1, 2 << lg); const float ic = 1.0f / (float)cnt;
            const f32x4 pv = sw * ic - hst[15 + r];
            v2u o; o.x = pk2(pv.x, pv.y); o.y = pk2(pv.z, pv.w);
            *(v2u*)(PL + (size_t)(m0 + r) * POOLW + 4 * lane) = o; }
    }
}

__device__ __forceinline__ void p11_qk_norm_rope(const Frame& F, const Ptrs& P) {
    bf16* Q = (bf16*)(P.ws + WS_QRAW); const bf16* KV = (const bf16*)P.out;   const bf16* KR = (const bf16*)(P.ws + WS_KROPE);
    bf16* KB = (bf16*)(P.ws + WS_KB); bf16* VT = (bf16*)(P.ws + WS_VT);
    const float* COS = (const float*)(P.ws + WS_COS); const float* SIN = (const float*)(P.ws + WS_SIN);
    const float* qg = P.in[17]; const float* kg = P.in[18];
    const int lane = F.lane, j = lane & 15; const int gw = F.bid * NWAVES + F.wave, NGW = F.G * NWAVES;
    float gqn[8], gkn[8], gqr[4], gkr[4];
#pragma unroll
    for (int k = 0; k < 8; ++k) { gqn[k] = qg[8 * j + k] * QSCALE; gkn[k] = kg[8 * j + k]; }
    gqr[0] = qg[128 + 2 * j] * QSCALE; gqr[1] = qg[129 + 2 * j] * QSCALE; gqr[2] = qg[160 + 2 * j] * QSCALE; gqr[3] = qg[161 + 2 * j] * QSCALE;
    gkr[0] = kg[128 + 2 * j]; gkr[1] = kg[129 + 2 * j]; gkr[2] = kg[160 + 2 * j]; gkr[3] = kg[161 + 2 * j];
    constexpr int NIT = 4; const int nsteps = M * NH / 4;
    for (int it0 = gw * NIT; it0 < nsteps; it0 += NGW * NIT) {
        v4u nqv[NIT]; unsigned xav[NIT], xbv[NIT]; float c0v[NIT], c1v[NIT], s0v[NIT], s1v[NIT];
#pragma unroll
        for (int k = 0; k < NIT; ++k) { const int it = min(it0 + k, nsteps - 1); const int item = it * 4 + (lane >> 4); const int m = item / NH, h = item - m * NH;
            nqv[k] = *(const v4u*)(KV + (size_t)m * NKV + h * 256 + 8 * j);
            const bf16* r1 = KR + (size_t)m * 64 + 2 * j; xav[k] = *(const unsigned*)r1; xbv[k] = *(const unsigned*)(r1 + 32);
            c0v[k] = COS[m * 32 + 2 * j]; c1v[k] = COS[m * 32 + 2 * j + 1]; s0v[k] = SIN[m * 32 + 2 * j]; s1v[k] = SIN[m * 32 + 2 * j + 1]; }
#pragma unroll
        for (int k = 0; k < NIT; ++k) { if (it0 + k >= nsteps) break;
            const int item = (it0 + k) * 4 + (lane >> 4); const int m = item / NH, h = item - m * NH;
            const v4u nq = nqv[k];
            float v[8] = {bflo(nq.x), bfhi(nq.x), bflo(nq.y), bfhi(nq.y), bflo(nq.z), bfhi(nq.z), bflo(nq.w), bfhi(nq.w)};
            float x1a = bflo(xav[k]), x1b = bfhi(xav[k]), x2a = bflo(xbv[k]), x2b = bfhi(xbv[k]);
            float ss = (x1a * x1a + x1b * x1b) + (x2a * x2a + x2b * x2b);
#pragma unroll
            for (int e = 0; e < 8; ++e) ss += v[e] * v[e];
            ss += __shfl_xor(ss, 1); ss += __shfl_xor(ss, 2); ss += __shfl_xor(ss, 4); ss += __shfl_xor(ss, 8);
            const float rstd = 1.0f / sqrtf(ss * (1.f / QKD) + EPS);
            v4u o; o.x = pk2(v[0] * rstd * gkn[0], v[1] * rstd * gkn[1]); o.y = pk2(v[2] * rstd * gkn[2], v[3] * rstd * gkn[3]); o.z = pk2(v[4] * rstd * gkn[4], v[5] * rstd * gkn[5]); o.w = pk2(v[6] * rstd * gkn[6], v[7] * rstd * gkn[7]);
            x1a *= rstd * gkr[0]; x1b *= rstd * gkr[1]; x2a *= rstd * gkr[2]; x2b *= rstd * gkr[3];
            const unsigned o1 = pk2(x1a * c0v[k] - x2a * s0v[k], x1b * c1v[k] - x2b * s1v[k]), o2 = pk2(x2a * c0v[k] + x1a * s0v[k], x2b * c1v[k] + x1b * s1v[k]);
            bf16* dst = KB + (size_t)m * NQ + h * QKD;
            *(v4u*)(dst + 8 * j) = o; *(unsigned*)(dst + 128 + 2 * j) = o1; *(unsigned*)(dst + 160 + 2 * j) = o2; }
    }
    constexpr int TP = 136; LAS bf16* sT = (LAS bf16*)F.lds;
    const int nvu = BATCH * NH * (SEQ / 64);
    v4u vin[2];
#define P11_VLOAD(uu) do { const int sb_ = (uu) & 31, bh_ = (uu) >> 5, b_ = bh_ / NH, h_ = bh_ - b_ * NH; const size_t t0_ = (size_t)b_ * SEQ + sb_ * 64; \
        _Pragma("unroll") for (int i = 0; i < 2; ++i) { const int id = F.tid + 512 * i, r = id >> 4, c = id & 15; vin[i] = *(const v4u*)(KV + (t0_ + r) * NKV + h_ * 256 + 128 + c * 8); } } while (0)
    if (F.bid < nvu) P11_VLOAD(F.bid);
    for (int u = F.bid; u < nvu; u += F.G) {
        const int sblk = u & 31, bh = u >> 5;
#pragma unroll
        for (int i = 0; i < 2; ++i) { const int id = F.tid + 512 * i, r = id >> 4, c = id & 15; *(LAS v4u*)(sT + r * TP + c * 8) = vin[i]; }
        __syncthreads();
        if (u + F.G < nvu) P11_VLOAD(u + F.G);
#pragma unroll
        for (int i = 0; i < 2; ++i) { const int id = F.tid + 512 * i, d = id >> 3, tg = id & 7;
            unsigned short e[8];
#pragma unroll
            for (int k = 0; k < 8; ++k) e[k] = sT[(16 * (tg >> 1) + 8 * (k >> 2) + 4 * (tg & 1) + (k & 3)) * TP + d];
            v4u o; o.x = e[0] | ((unsigned)e[1] << 16); o.y = e[2] | ((unsigned)e[3] << 16); o.z = e[4] | ((unsigned)e[5] << 16); o.w = e[6] | ((unsigned)e[7] << 16);
            *(v4u*)(VT + ((size_t)bh * 128 + d) * SEQ + sblk * 64 + tg * 8) = o; }
        __syncthreads();
    }
}

template <bool FIXED> __device__ __forceinline__ void p12_attention_t(const Frame& F, const Ptrs& P, const float Cb) {
    constexpr int KP = 200, VP = 72;
    constexpr int KBUF = 64 * KP, VBUF = 128 * VP;
    LAS bf16* sK = (LAS bf16*)F.lds;
    LAS bf16* sV = (LAS bf16*)(F.lds + 2 * KBUF * 2);
    const bf16* Q = (const bf16*)(P.ws + WS_QRAW); const bf16* KB = (const bf16*)(P.ws + WS_KB); const bf16* VT = (const bf16*)(P.ws + WS_VT);
    bf16* MIX = (bf16*)(P.ws + WS_MIX);
    const int tid = F.tid, lane = F.lane, w = F.wave, ql = lane & 31, g = lane >> 5;
    const int nrounds = (768 + F.G - 1) / F.G;
    for (int rd = 0; rd < nrounds; ++rd) {
        const int idx = rd * F.G + ((rd & 1) ? (F.G - 1 - F.bid) : F.bid);
        if (idx >= 768) continue;
        const int jb = 7 - idx / 96, bh = idx % 96, b = bh / NH, h = bh - b * NH;
        const int qrow = 256 * jb + 32 * w + ql; const size_t tokq = (size_t)b * SEQ + qrow;
        bf16x8 qf[12];
        {
            v4u qr[12]; float ss = 0.f;
#pragma unroll
            for (int ds = 0; ds < 12; ++ds) { qr[ds] = *(const v4u*)(Q + tokq * NQ + h * QKD + ds * 16 + g * 8);
                const float a0 = bflo(qr[ds].x), a1 = bfhi(qr[ds].x), a2 = bflo(qr[ds].y), a3 = bfhi(qr[ds].y), a4 = bflo(qr[ds].z), a5 = bfhi(qr[ds].z), a6 = bflo(qr[ds].w), a7 = bfhi(qr[ds].w);
                ss += ((a0 * a0 + a1 * a1) + (a2 * a2 + a3 * a3)) + ((a4 * a4 + a5 * a5) + (a6 * a6 + a7 * a7)); }
            ss += __shfl_xor(ss, 32);
            const float rq = QSCALE / sqrtf(ss * (1.f / QKD) + EPS);
            const float* qg = P.in[17];
#pragma unroll
            for (int ds = 0; ds < 8; ++ds) { const f32x4 g0 = *(const f32x4*)(qg + ds * 16 + g * 8), g1 = *(const f32x4*)(qg + ds * 16 + g * 8 + 4);
                v4u w; w.x = pk2(bflo(qr[ds].x) * rq * g0.x, bfhi(qr[ds].x) * rq * g0.y); w.y = pk2(bflo(qr[ds].y) * rq * g0.z, bfhi(qr[ds].y) * rq * g0.w);
                w.z = pk2(bflo(qr[ds].z) * rq * g1.x, bfhi(qr[ds].z) * rq * g1.y); w.w = pk2(bflo(qr[ds].w) * rq * g1.z, bfhi(qr[ds].w) * rq * g1.w);
                qf[ds] = __builtin_bit_cast(bf16x8, w); }
            const float* COS = (const float*)(P.ws + WS_COS) + tokq * 32; const float* SIN = (const float*)(P.ws + WS_SIN) + tokq * 32;
#pragma unroll
            for (int dr = 0; dr < 2; ++dr) { const int i0 = dr * 16 + g * 8;
                float x1[8], x2[8], cs[8], sn[8];
                { const v4u a = qr[8 + dr], b = qr[10 + dr];
                  x1[0] = bflo(a.x); x1[1] = bfhi(a.x); x1[2] = bflo(a.y); x1[3] = bfhi(a.y); x1[4] = bflo(a.z); x1[5] = bfhi(a.z); x1[6] = bflo(a.w); x1[7] = bfhi(a.w);
                  x2[0] = bflo(b.x); x2[1] = bfhi(b.x); x2[2] = bflo(b.y); x2[3] = bfhi(b.y); x2[4] = bflo(b.z); x2[5] = bfhi(b.z); x2[6] = bflo(b.w); x2[7] = bfhi(b.w); }
#pragma unroll
                for (int e4 = 0; e4 < 2; ++e4) { const f32x4 c = *(const f32x4*)(COS + i0 + 4 * e4), sv = *(const f32x4*)(SIN + i0 + 4 * e4), ga = *(const f32x4*)(qg + 128 + i0 + 4 * e4), gb = *(const f32x4*)(qg + 160 + i0 + 4 * e4);
#pragma unroll
                    for (int k = 0; k < 4; ++k) { cs[4 * e4 + k] = c[k]; sn[4 * e4 + k] = sv[k]; x1[4 * e4 + k] *= rq * ga[k]; x2[4 * e4 + k] *= rq * gb[k]; } }
                v4u w1, w2;
                w1.x = pk2(x1[0] * cs[0] - x2[0] * sn[0], x1[1] * cs[1] - x2[1] * sn[1]); w1.y = pk2(x1[2] * cs[2] - x2[2] * sn[2], x1[3] * cs[3] - x2[3] * sn[3]);
                w1.z = pk2(x1[4] * cs[4] - x2[4] * sn[4], x1[5] * cs[5] - x2[5] * sn[5]); w1.w = pk2(x1[6] * cs[6] - x2[6] * sn[6], x1[7] * cs[7] - x2[7] * sn[7]);
                w2.x = pk2(x2[0] * cs[0] + x1[0] * sn[0], x2[1] * cs[1] + x1[1] * sn[1]); w2.y = pk2(x2[2] * cs[2] + x1[2] * sn[2], x2[3] * cs[3] + x1[3] * sn[3]);
                w2.z = pk2(x2[4] * cs[4] + x1[4] * sn[4], x2[5] * cs[5] + x1[5] * sn[5]); w2.w = pk2(x2[6] * cs[6] + x1[6] * sn[6], x2[7] * cs[7] + x1[7] * sn[7]);
                qf[8 + dr] = __builtin_bit_cast(bf16x8, w1); qf[10 + dr] = __builtin_bit_cast(bf16x8, w2); }
        }
        f32x16 o[4];
#pragma unroll
        for (int i = 0; i < 4; ++i)
#pragma unroll
            for (int r = 0; r < 16; ++r) o[i][r] = 0.f;
        float mrun = -INFINITY, lrun = 0.f;
        const int ntiles = 4 * (jb + 1), mylast = 4 * jb + (w >> 1);
        const bf16* kbase = KB + ((size_t)b * SEQ) * NQ + h * QKD; const bf16* vbase = VT + (size_t)bh * 128 * SEQ;
        v4u kr[3], vr[2];
        const bf16* kthr = kbase + (size_t)(tid >> 3) * NQ + (tid & 7) * 8; const bf16* vthr = vbase + (size_t)(tid >> 2) * SEQ + (tid & 3) * 8;
        LAS bf16* skthr = sK + (tid >> 3) * KP + (tid & 7) * 8; LAS bf16* svthr = sV + (tid >> 2) * VP + (tid & 3) * 8;
#define ATT_LOAD(t) do { _Pragma("unroll") for (int i = 0; i < 3; ++i) kr[i] = *(const v4u*)(kthr + (size_t)(t) * 64 * NQ + i * 64); \
            _Pragma("unroll") for (int i = 0; i < 2; ++i) vr[i] = *(const v4u*)(vthr + (t) * 64 + i * 32); } while (0)
#define ATT_STORE(bf) do { _Pragma("unroll") for (int i = 0; i < 3; ++i) *(LAS v4u*)(skthr + (bf) * KBUF + i * 64) = kr[i]; \
            _Pragma("unroll") for (int i = 0; i < 2; ++i) *(LAS v4u*)(svthr + (bf) * VBUF + i * 32) = vr[i]; } while (0)
        ATT_LOAD(0); ATT_STORE(0);
        __syncthreads();
        for (int t = 0; t < ntiles; ++t) {
            const int bf = t & 1;
            if (t + 1 < ntiles) ATT_LOAD(t + 1);
            if (t <= mylast) {
                f32x16 s[2];
                __builtin_amdgcn_s_setprio(1);
#pragma unroll
                for (int sub = 0; sub < 2; ++sub) {
#pragma unroll
                    for (int r = 0; r < 16; ++r) s[sub][r] = 0.f;
#pragma unroll
                    for (int ds = 0; ds < 12; ++ds) { const bf16x8 kf = *(const LAS bf16x8*)(sK + bf * KBUF + (sub * 32 + ql) * KP + ds * 16 + g * 8);
                        s[sub] = __builtin_amdgcn_mfma_f32_32x32x16_bf16(kf, qf[ds], s[sub], 0, 0, 0); }
                }
                __builtin_amdgcn_s_setprio(0);
                if (t >= 4 * jb) {
#pragma unroll
                    for (int sub = 0; sub < 2; ++sub)
#pragma unroll
                        for (int r = 0; r < 16; ++r) { const int kin = t * 64 + sub * 32 + 8 * (r >> 2) + 4 * g + (r & 3); if (kin > qrow) s[sub][r] = -INFINITY; }
                }
                bf16x8 pf[4];
                if constexpr (FIXED) {
                    __builtin_amdgcn_sched_barrier(0);
                    float rs0 = 0.f;
#pragma unroll
                    for (int kt = 0; kt < 4; ++kt) { const int sub = kt >> 1, r0 = 8 * (kt & 1); float e[8];
#pragma unroll
                        for (int k = 0; k < 8; ++k) e[k] = __builtin_amdgcn_exp2f(s[sub][r0 + k]);
                        rs0 += ((e[0] + e[1]) + (e[2] + e[3])) + ((e[4] + e[5]) + (e[6] + e[7]));
                        v4u pw; pw.x = pk2(e[0], e[1]); pw.y = pk2(e[2], e[3]); pw.z = pk2(e[4], e[5]); pw.w = pk2(e[6], e[7]);
                        pf[kt] = __builtin_bit_cast(bf16x8, pw); }
                    rs0 += __shfl_xor(rs0, 32);
                    lrun += rs0;
                    __builtin_amdgcn_sched_barrier(0);
                } else {
                float mx = s[0][0];
#pragma unroll
                for (int sub = 0; sub < 2; ++sub)
#pragma unroll
                    for (int r = 0; r < 16; ++r) mx = fmaxf(mx, s[sub][r]);
                mx = fmaxf(mx, __shfl_xor(mx, 32));
                const float mnew = fmaxf(mrun, mx); const float alpha = __builtin_amdgcn_exp2f(mrun - mnew); mrun = mnew;
                float rs = 0.f;
#pragma unroll
                for (int sub = 0; sub < 2; ++sub)
#pragma unroll
                    for (int r = 0; r < 16; ++r) { s[sub][r] = __builtin_amdgcn_exp2f(s[sub][r] - mnew); rs += s[sub][r]; }
                rs += __shfl_xor(rs, 32);
                lrun = lrun * alpha + rs;
                if (__any(alpha != 1.0f)) {
#pragma unroll
                for (int i = 0; i < 4; ++i)
#pragma unroll
                    for (int r = 0; r < 16; ++r) o[i][r] *= alpha; }
#pragma unroll
                for (int kt = 0; kt < 4; ++kt) { const int sub = kt >> 1, r0 = 8 * (kt & 1);
                    v4u pw; pw.x = pk2(s[sub][r0 + 0], s[sub][r0 + 1]); pw.y = pk2(s[sub][r0 + 2], s[sub][r0 + 3]); pw.z = pk2(s[sub][r0 + 4], s[sub][r0 + 5]); pw.w = pk2(s[sub][r0 + 6], s[sub][r0 + 7]);
                    pf[kt] = __builtin_bit_cast(bf16x8, pw); }
                }
                __builtin_amdgcn_s_setprio(1);
#pragma unroll
                for (int dsub = 0; dsub < 4; ++dsub)
#pragma unroll
                    for (int kt = 0; kt < 4; ++kt) { const bf16x8 vf = *(const LAS bf16x8*)(sV + bf * VBUF + (dsub * 32 + ql) * VP + kt * 16 + 8 * g);
                        o[dsub] = __builtin_amdgcn_mfma_f32_32x32x16_bf16(vf, pf[kt], o[dsub], 0, 0, 0); }
                __builtin_amdgcn_s_setprio(0);
            }
            if (t + 1 < ntiles) ATT_STORE(bf ^ 1);
            __syncthreads();
        }
#undef ATT_LOAD
#undef ATT_STORE
        const float il = 1.0f / lrun;
        bf16* orow = MIX + tokq * D + 256 + h * 128;
#pragma unroll
        for (int dsub = 0; dsub < 4; ++dsub)
#pragma unroll
            for (int k2 = 0; k2 < 2; ++k2) {
                v2u A, B;
                A.x = pk2(o[dsub][8 * k2 + 0] * il, o[dsub][8 * k2 + 1] * il); A.y = pk2(o[dsub][8 * k2 + 2] * il, o[dsub][8 * k2 + 3] * il);
                B.x = pk2(o[dsub][8 * k2 + 4] * il, o[dsub][8 * k2 + 5] * il); B.y = pk2(o[dsub][8 * k2 + 6] * il, o[dsub][8 * k2 + 7] * il);
                const unsigned sx = g ? A.x : B.x, sy = g ? A.y : B.y;
                const unsigned rx = (unsigned)__shfl_xor((int)sx, 32), ry = (unsigned)__shfl_xor((int)sy, 32);
                v4u ov; if (g == 0) { ov.x = A.x; ov.y = A.y; ov.z = rx; ov.w = ry; } else { ov.x = rx; ov.y = ry; ov.z = B.x; ov.w = B.y; }
                *(v4u*)(orow + dsub * 32 + 16 * k2 + 8 * g) = ov; }
    }
}
__device__ __forceinline__ void p12_attention(const Frame& F, const Ptrs& P) {
    float gqm = 0.f, gkm = 0.f;
    for (int i = F.lane; i < QKD; i += 64) { gqm = fmaxf(gqm, fabsf(P.in[17][i])); gkm = fmaxf(gkm, fabsf(P.in[18][i])); }
#pragma unroll
    for (int o = 1; o < 64; o <<= 1) { gqm = fmaxf(gqm, __shfl_xor(gqm, o)); gkm = fmaxf(gkm, __shfl_xor(gkm, o)); }
    const float Cb = __builtin_bit_cast(float, __builtin_amdgcn_readfirstlane(__builtin_bit_cast(int, (float)QKD * gqm * gkm * QSCALE * 1.06f + 0.5f)));
    if (Cb < 40.f) p12_attention_t<true>(F, P, Cb); else p12_attention_t<false>(F, P, Cb);
}

#define XB_TMO      128
#define XB_XCNT(j)  (256  + 64 * (j))
#define XB_XSUB(j)  (1280 + 64 * (j))
#define XB_XGEN(j)  (2304 + 64 * (j))
#define XB_TOP      3328
#define XB_TOPGEN   3392
#define XCD_BAR_WORDS 3456
#define XB_SPIN_CAP (1u << 18)

__device__ __forceinline__ unsigned xb_ld(unsigned* p)              { return __hip_atomic_load(p, __ATOMIC_RELAXED, __HIP_MEMORY_SCOPE_AGENT); }
__device__ __forceinline__ unsigned xb_add(unsigned* p, unsigned v) { return __hip_atomic_fetch_add(p, v, __ATOMIC_RELAXED, __HIP_MEMORY_SCOPE_AGENT); }
__device__ __forceinline__ unsigned xb_xcc_id() { return (unsigned)__builtin_amdgcn_s_getreg((3 << 11) | 20) & 0xFu; }
#define XB_SPIN(cond, bar) do { unsigned _sp = 0; while (cond) { __builtin_amdgcn_s_sleep(1); \
    if ((++_sp & 255u) == 0u) { if (xb_ld(&(bar)[XB_TMO])) break; if (_sp > XB_SPIN_CAP) { atomicAdd(&(bar)[XB_TMO], 1u); break; } } } } while (0)

struct XcdBarrier {
    unsigned* bar; unsigned x;
    volatile LAS unsigned* st;
};

__device__ __forceinline__ XcdBarrier xcd_barrier_post(unsigned* bar, volatile LAS unsigned* st) {
    XcdBarrier b; b.bar = bar; b.x = xb_xcc_id(); b.st = st;
    if (threadIdx.x == 0) (void)xb_add(&bar[XB_XCNT(b.x)], 1u);
    return b;
}
__device__ __forceinline__ void xcd_barrier_complete(unsigned* bar, unsigned x, unsigned& nloc, unsigned& nx) {
    const unsigned G = gridDim.x * gridDim.y * gridDim.z;
    unsigned sum, cnt, mine, sp = 0u;
    for (;;) {
        sum = 0u; cnt = 0u; mine = 0u;
#pragma unroll
        for (unsigned j = 0; j < 16; ++j) { const unsigned c = xb_ld(&bar[XB_XCNT(j)]); sum += c; cnt += (c > 0u) ? 1u : 0u; mine = (j == x) ? c : mine; }
        if (sum == G) break;
        __builtin_amdgcn_s_sleep(1);
        if ((++sp & 255u) == 0u) { if (xb_ld(&bar[XB_TMO])) break; if (sp > XB_SPIN_CAP) { atomicAdd(&bar[XB_TMO], 1u); break; } }
    }
    nloc = mine > 0u ? mine : 1u; nx = cnt > 0u ? cnt : 1u;
}

__device__ __forceinline__ void xcd_barrier(const XcdBarrier& b) {
    asm volatile("s_waitcnt vmcnt(0)" ::: "memory");
    __syncthreads();
    if (threadIdx.x == 0) {
        unsigned* bar = b.bar;
        __builtin_amdgcn_s_waitcnt(0);
        unsigned nloc = b.st[0], nx = b.st[1];
        if (nloc == 0u) { xcd_barrier_complete(bar, b.x, nloc, nx); b.st[0] = nloc; b.st[1] = nx; }
        const unsigned old = xb_add(&bar[XB_XSUB(b.x)], 1u);
        const unsigned gen = old / nloc;
        if (old + 1u == (gen + 1u) * nloc) {
            __builtin_amdgcn_fence(__ATOMIC_RELEASE, "agent");
            asm volatile("s_waitcnt vmcnt(0)" ::: "memory");
            const unsigned og = xb_add(&bar[XB_TOP], 1u);
            const unsigned tg = og / nx;
            if (og + 1u == (tg + 1u) * nx) xb_add(&bar[XB_TOPGEN], 1u);
            else XB_SPIN(xb_ld(&bar[XB_TOPGEN]) == tg, bar);
            __builtin_amdgcn_fence(__ATOMIC_ACQUIRE, "agent");
            xb_add(&bar[XB_XGEN(b.x)], 1u);
            asm volatile("s_waitcnt vmcnt(0)" ::: "memory");
        } else {
            XB_SPIN(xb_ld(&bar[XB_XGEN(b.x)]) == gen, bar);
            __builtin_amdgcn_fence(__ATOMIC_ACQUIRE, "agent");
            asm volatile("s_waitcnt vmcnt(0)" ::: "memory");
        }
    }
    __syncthreads();
}


__device__ __forceinline__ pg8::RowScale build_rowscale(const Frame& F, const pg8::StaticOrder& S, const float* ssq) {
    pg8::RowScale R; R.tab = (const LAS float*)(F.lds + RSTAB_OFF); R.ssq = ssq; R.pm0 = R.pm1 = R.pm2 = R.pm3 = -1;
    int nd = 0; pg8::Unit u;
    for (int i = 0; S.next(i, u); ++i) { const int pm = u.pm;
        if (pm == R.pm0 || pm == R.pm1 || pm == R.pm2 || pm == R.pm3) continue;
        if (nd == 0) R.pm0 = pm; else if (nd == 1) R.pm1 = pm; else if (nd == 2) R.pm2 = pm; else if (nd == 3) R.pm3 = pm;
        ++nd; }
    if (nd > 4) nd = 4;
    LAS float* tab = (LAS float*)(F.lds + RSTAB_OFF);
    for (int idx = F.tid; idx < nd * 256; idx += NTHR) { const int slot = idx >> 8, rl = idx & 255; const int pm = slot == 0 ? R.pm0 : (slot == 1 ? R.pm1 : (slot == 2 ? R.pm2 : R.pm3));
        const f32x4* p = (const f32x4*)(ssq + (size_t)(pm * 256 + rl) * 16); const f32x4 a = (p[0] + p[1]) + (p[2] + p[3]);
        tab[idx] = 1.0f / sqrtf(((a[0] + a[1]) + (a[2] + a[3])) * (1.f / 1024.f) + EPS); }
    __syncthreads();
    return R;
}
typedef pg8::EpiRes<true, false, true> EpiResIn; typedef pg8::EpiRes<false, false, true> EpiResMid; typedef pg8::EpiRes<false, true, false> EpiResOut;
struct Args { const float* in[23]; float* out; unsigned char* ws; int ph_lo, ph_hi; };
constexpr int NPHASE = 17;
#define GEMM_PHASE(EpiT, Aptr, Bptr, Nn, Kk, cidx, ...) do { pg8::Gemm g_{(const pg8::bf16_t*)(Aptr), (const pg8::bf16_t*)(Bptr), M, (Nn), (Kk)}; pg8::StaticOrder S_; S_.init(M, (Nn), F.G, (cidx)); \
        EpiT E_{__VA_ARGS__}; pg8::gemm_phase<EpiT, pg8::StaticOrder, true, true>(F.lds, g_, S_, E_); } while (0)

#define GEMM_PHASE_RS(EpiT, Aptr, Bptr, Nn, Kk, cidx, ...) do { pg8::Gemm g_{(const pg8::bf16_t*)(Aptr), (const pg8::bf16_t*)(Bptr), M, (Nn), (Kk)}; pg8::StaticOrder S_; S_.init(M, (Nn), F.G, (cidx)); \
        const pg8::RowScale RS_ = build_rowscale(F, S_, SSQ); EpiT E_{__VA_ARGS__, RS_}; pg8::gemm_phase<EpiT, pg8::StaticOrder, true, true>(F.lds, g_, S_, E_); } while (0)
__global__ void __launch_bounds__(NTHR, 2) trunk_fwd(Args args) {
    extern __shared__ __attribute__((aligned(16))) unsigned char lds_raw[];
    cg::grid_group grid = cg::this_grid();
    Frame F; F.lds = (LAS unsigned char*)lds_raw; F.tid = threadIdx.x; F.lane = F.tid & 63; F.wave = __builtin_amdgcn_readfirstlane(F.tid >> 6); F.G = gridDim.x; F.bid = blockIdx.x;
    Ptrs P;
#pragma unroll
    for (int i = 0; i < 23; ++i) P.in[i] = args.in[i];
    P.pos = (const int*)args.in[1]; P.out = args.out; P.ws = args.ws;
    unsigned char* ws = args.ws; float* X = args.out; bf16* XB = (bf16*)(ws + WS_XB); float* SSQ = (float*)(ws + WS_SSQ);
    const int lo = args.ph_lo, hi = args.ph_hi;
    volatile LAS unsigned* xst = (volatile LAS unsigned*)(F.lds + 131072);
    if (F.tid < 4) xst[F.tid] = 0u;
    __syncthreads();
    XcdBarrier xbar = xcd_barrier_post((unsigned*)ws, xst);
    if (hi < 0) grid.sync();
#ifndef PH_MASK
#define PH_MASK 0x1ffff
#endif
#define PH_BEGIN(k) if (((PH_MASK >> (k)) & 1) && lo <= (k) && (k) < hi) {
#ifdef PROBE_SYNC
#define PH_END(k) if ((k) + 1 < hi) { xcd_barrier(xbar); xcd_barrier(xbar); } }
#else
#define PH_END(k) if ((k) + 1 < hi) xcd_barrier(xbar); }
#endif
    PH_BEGIN(0) p0_prologue(F, P);
#ifdef PROBE_DUP0
        xcd_barrier(xbar); p0_prologue(F, P);
#endif
    PH_END(0)
    PH_BEGIN(1) GEMM_PHASE(pg8::EpiStoreBf16, ws + WS_XN, ws + WS_WIN0, EVEN_IN, D, F.bid, (pg8::bf16_t*)(ws + WS_PROJ0), EVEN_IN, 1024, EVEN_IN, nullptr, false, pg8::RowScale{}); PH_END(1)
    PH_BEGIN(2) p2_even_mixer(F, P);
#ifdef PROBE_DUP2
        xcd_barrier(xbar); p2_even_mixer(F, P);
#endif
    PH_END(2)
    PH_BEGIN(3) GEMM_PHASE(EpiResIn, ws + WS_MIX, ws + WS_WOUT0, D, D, F.bid, P.in[0], XB, D, SSQ); PH_END(3)
    PH_BEGIN(5) GEMM_PHASE_RS(pg8::EpiSwiGLU, XB, ws + WS_WGU, NGU, D, F.bid, (pg8::bf16_t*)(ws + WS_ACT), DFF); PH_END(5)
    PH_BEGIN(6) GEMM_PHASE(EpiResMid, ws + WS_ACT, ws + WS_WDN, D, DFF, F.bid, XB, XB, D, SSQ); PH_END(6)
    PH_BEGIN(8) GEMM_PHASE_RS(pg8::EpiStoreBf16, XB, ws + WS_WIN1, ODD_IN_P, D, F.bid, (pg8::bf16_t*)(ws + WS_PROJ1), ODD_IN_P, 0, ODD_IN_P, nullptr, true); PH_END(8)
    PH_BEGIN(9) p9_token_ops(F, P);
#ifdef PROBE_DUP9
        xcd_barrier(xbar); p9_token_ops(F, P);
#endif
    PH_END(9)
    PH_BEGIN(10)
        GEMM_PHASE(pg8::EpiStoreBf16, ws + WS_QN, ws + WS_WQB, NQ_P, QLORA, F.bid, (pg8::bf16_t*)(ws + WS_QRAW), NQ, 0, NQ, nullptr, false, pg8::RowScale{});
        GEMM_PHASE(pg8::EpiStoreBf16, ws + WS_KVN, ws + WS_WKVB, NKV, KVLORA, F.bid, (pg8::bf16_t*)X, NKV, 0, NKV, nullptr, false, pg8::RowScale{});
        GEMM_PHASE(pg8::EpiStoreBf16, ws + WS_POOLED, ws + WS_WPOOL, POOLW, POOLW, (F.bid + F.G / 2) % F.G, (pg8::bf16_t*)(ws + WS_MIX), D, 0, POOLW, P.in[12], false, pg8::RowScale{});
    PH_END(10)
    PH_BEGIN(11) p11_qk_norm_rope(F, P); PH_END(11)
    PH_BEGIN(12) p12_attention(F, P);
#ifdef PROBE_DUP12
        xcd_barrier(xbar); p12_attention(F, P);
#endif
    PH_END(12)
    PH_BEGIN(13) GEMM_PHASE(EpiResMid, ws + WS_MIX, ws + WS_WOUT1, D, D, F.bid, XB, XB, D, SSQ); PH_END(13)
    PH_BEGIN(15) GEMM_PHASE_RS(pg8::EpiSwiGLU, XB, (bf16*)(ws + WS_WGU) + (size_t)NGU * D, NGU, D, F.bid, (pg8::bf16_t*)(ws + WS_ACT), DFF); PH_END(15)
    PH_BEGIN(16) GEMM_PHASE(EpiResOut, ws + WS_ACT, (bf16*)(ws + WS_WDN) + (size_t)D * DFF, D, DFF, F.bid, XB, X, D, nullptr); PH_END(16)
}

#ifndef MK_MULTI
#define MK_MULTI 0
#endif
extern "C" void kernel_launch(void* const* d_in, const int* in_sizes, int n_in, void* d_out, int out_size, void* d_ws, size_t ws_size, hipStream_t stream) {
    static int grid = 0;
    if (grid == 0) {
        if (n_in != 23 || in_sizes[0] != M * D || out_size != M * D || ws_size < WS_END) { fprintf(stderr, "kernel_launch: unexpected shapes (n_in %d, in0 %d, out %d, ws %zu)\n", n_in, n_in > 0 ? in_sizes[0] : -1, out_size, ws_size); grid = -1; return; }
        int dev = 0, cus = 0, per_cu = 0;
        (void)hipGetDevice(&dev); (void)hipDeviceGetAttribute(&cus, hipDeviceAttributeMultiprocessorCount, dev);
        if (hipFuncSetAttribute((const void*)trunk_fwd, hipFuncAttributeMaxDynamicSharedMemorySize, LDS_BYTES) != hipSuccess) { fprintf(stderr, "kernel_launch: hipFuncSetAttribute failed\n"); grid = -1; return; }
        if (hipOccupancyMaxActiveBlocksPerMultiprocessor(&per_cu, (const void*)trunk_fwd, NTHR, LDS_BYTES) != hipSuccess || per_cu < 1) { fprintf(stderr, "kernel_launch: occupancy query failed (%d)\n", per_cu); per_cu = 1; }
        (void)hipGetLastError();
        grid = cus;
        if (grid > cus * per_cu) grid = cus * per_cu;
    }
    if (grid < 0) return;
    if (hipMemsetAsync(d_ws, 0, 16384, stream) != hipSuccess) { fprintf(stderr, "kernel_launch: memset of the barrier words failed\n"); return; }
    Args a{};
    for (int i = 0; i < 23; ++i) a.in[i] = (const float*)d_in[i];
    a.out = (float*)d_out; a.ws = (unsigned char*)d_ws;
#if MK_MULTI
    for (int p = 0; p < NPHASE; ++p) { a.ph_lo = p; a.ph_hi = p + 1; hipLaunchKernelGGL(trunk_fwd, dim3(grid), dim3(NTHR), LDS_BYTES, stream, a); }
#else
    a.ph_lo = 0; a.ph_hi = NPHASE;
    void* kargs[] = {&a};
    hipError_t e = hipLaunchCooperativeKernel((const void*)trunk_fwd, dim3(grid), dim3(NTHR), kargs, LDS_BYTES, stream);
    if (e != hipSuccess) fprintf(stderr, "kernel_launch: cooperative launch failed: %s (grid %d)\n", hipGetErrorString(e), grid);
#endif
}
```

```cpp
#include <hip/hip_runtime.h>
#include <hip/hip_cooperative_groups.h>
#include <cstdio>
#include <cstdint>
namespace cg = cooperative_groups;
namespace pg8 {
#define PG8_LAS __attribute__((address_space(3)))
typedef unsigned short bf16_t;
typedef short bf16x8 __attribute__((ext_vector_type(8)));
typedef float f32x4 __attribute__((ext_vector_type(4)));
typedef unsigned u32x4 __attribute__((ext_vector_type(4)));
constexpr int BM = 256, BK = 64, HALF = 128, HTB = HALF * BK * 2  , STAGE_BYTES = 8 * HTB, NXCD = 8, WGM = 8;

__host__ __device__ __forceinline__ int lds_byte(int r, int c) { const int st = (r >> 4) * 2 + (c >> 5), rr = r & 15, cc = c & 31, ob = rr * 64 + cc * 2; return st * 1024 + (ob ^ (((ob >> 9) & 1) << 5)); }
__host__ __device__ __forceinline__ void stage_rc(int b, int& R, int& C) { const int st = b / 1024, sb = b % 1024, swz = sb ^ (((sb >> 9) & 1) << 5); R = (st >> 1) * 16 + swz / 64; C = (st & 1) * 32 + (swz % 64) / 2; }
__host__ __device__ __forceinline__ int perm32(int rho) { const int n = rho >> 4, i = rho & 15; return 8 * (i >> 2) + 4 * n + (i & 3); }

struct Unit { int pm, pn; };
struct Gemm { const bf16_t* A; const bf16_t* Bt; int M, N, K; };

struct StaticOrder {
    int nM, nN, nwg, G, c;
    __host__ __device__ void init(int M, int N, int G_, int c_) { nM = M / BM; nN = N / BM; nwg = nM * nN; G = G_; c = c_; }
    __host__ __device__ bool next(int i, Unit& u) const {
        const long L = (long)i * G + c; if (L >= nwg) return false;
        int wgid = (int)L; { const int q = nwg / NXCD, r = nwg % NXCD, xcd = wgid % NXCD, off = wgid / NXCD; wgid = (xcd < r ? xcd * (q + 1) : r * (q + 1) + (xcd - r) * q) + off; }
        const int nig = WGM * nN, gid = wgid / nig, fm = gid * WGM, gsz = (nM - fm) < WGM ? (nM - fm) : WGM;
        u.pm = fm + ((wgid % nig) % gsz); u.pn = (wgid % nig) / gsz; return true;
    }
    __device__ __forceinline__ void a_ready(const Unit&) const {}
    __device__ __forceinline__ void done(const Unit&) const {}
};

__device__ __forceinline__ unsigned cvt_pk_bf16(float lo, float hi) { unsigned r; asm volatile("v_cvt_pk_bf16_f32 %0, %1, %2" : "=v"(r) : "v"(lo), "v"(hi)); return r; }
typedef float f32x2 __attribute__((ext_vector_type(2)));
__device__ __forceinline__ f32x2 gelu_pk(f32x2 v) {
    const f32x2 av = __builtin_elementwise_abs(v), d = av * 0.2316418882f + 1.0f;
    f32x2 t; t.x = __builtin_amdgcn_rcpf(d.x); t.y = __builtin_amdgcn_rcpf(d.y);
    f32x2 q = t * 0.5307027145f + (-0.7265760135f); q = q * t + 0.7107068705f; q = q * t + (-0.142248368f); q = q * t + 0.127414796f; q = q * t;
    const f32x2 s = (v * v) * (-0.72134752044f);
    f32x2 e; e.x = __builtin_amdgcn_exp2f(s.x); e.y = __builtin_amdgcn_exp2f(s.y);
    const f32x2 m = v * (q * e), r = v - m;
    f32x2 o; o.x = v.x < 0.f ? m.x : r.x; o.y = v.y < 0.f ? m.y : r.y; return o;
}

struct RowScale {
    const PG8_LAS float* tab; const float* ssq; int pm0, pm1, pm2, pm3;
    __device__ __forceinline__ float get(int pm, int rl) const {
        const int slot = pm == pm0 ? 0 : (pm == pm1 ? 1 : (pm == pm2 ? 2 : (pm == pm3 ? 3 : -1)));
        if (slot >= 0) return tab[slot * 256 + rl];
        const f32x4* p = (const f32x4*)(ssq + (size_t)(pm * BM + rl) * 16); const f32x4 a = (p[0] + p[1]) + (p[2] + p[3]);
        return 1.0f / sqrtf(((a[0] + a[1]) + (a[2] + a[3])) * (1.f / 1024.f) + 1e-6f);
    }
};
struct EpiStoreBf16 {
    static constexpr bool PERM = true, AFTER_DRAIN = false;
    bf16_t* O; int ldc; int gelu_cols; int ncols; const float* cscale; bool rowsc; RowScale rsc;
    __device__ __forceinline__ void operator()(const f32x4 (&acc)[2][2][4][2], const Unit& u, int wr, int wc, int fr, int fq) const {
        const int row0 = u.pm * BM + wr * 64 + fr; const int colt = u.pn * BM; const int col0 = colt + wc * 32 + 8 * fq;
        const bool act = colt < gelu_cols;
        f32x4 sv[2][2];
#pragma unroll
        for (int bj = 0; bj < 2; ++bj)
#pragma unroll
            for (int n = 0; n < 2; ++n) sv[bj][n] = (cscale && (col0 + bj * HALF) < ncols) ? *(const f32x4*)(cscale + col0 + bj * HALF + 4 * n) : (f32x4){1.f, 1.f, 1.f, 1.f};
#pragma unroll
        for (int ai = 0; ai < 2; ++ai)
#pragma unroll
            for (int m = 0; m < 4; ++m) { bf16_t* rowp = O + (size_t)(row0 + ai * HALF + m * 16) * ldc + col0;
                const float rs = rowsc ? rsc.get(u.pm, ai * HALF + wr * 64 + m * 16 + fr) : 1.f;
#pragma unroll
                for (int bj = 0; bj < 2; ++bj) { f32x4 v0 = acc[ai][bj][m][0], v1 = acc[ai][bj][m][1];
                    if (act) { f32x2 a = gelu_pk((f32x2){v0[0], v0[1]}), b = gelu_pk((f32x2){v0[2], v0[3]}), c = gelu_pk((f32x2){v1[0], v1[1]}), d = gelu_pk((f32x2){v1[2], v1[3]});
                        v0 = (f32x4){a.x, a.y, b.x, b.y}; v1 = (f32x4){c.x, c.y, d.x, d.y}; }
                    v0 = v0 * sv[bj][0] * rs; v1 = v1 * sv[bj][1] * rs;
                    u32x4 w; w.x = cvt_pk_bf16(v0[0], v0[1]); w.y = cvt_pk_bf16(v0[2], v0[3]); w.z = cvt_pk_bf16(v1[0], v1[1]); w.w = cvt_pk_bf16(v1[2], v1[3]);
                    if (col0 + bj * HALF < ncols) *(u32x4*)(rowp + bj * HALF) = w; } }
    }
};
template <bool BASE_F32, bool OUT_F32, bool SSQW> struct EpiRes {
    static constexpr bool PERM = true, AFTER_DRAIN = false;
    const void* base; void* out; int ldc; float* ssq;
    __device__ __forceinline__ void operator()(const f32x4 (&acc)[2][2][4][2], const Unit& u, int wr, int wc, int fr, int fq) const {
        const int row0 = u.pm * BM + wr * 64 + fr, col0 = u.pn * BM + wc * 32 + 8 * fq;
        const size_t off0 = (size_t)row0 * ldc + col0;
        f32x4 bf[2][2][2][2];
        u32x4 bh[2][2][2];
#define ER_OFF(k, mm, bj) (off0 + (size_t)(((k) >> 1) * HALF + (((k) & 1) * 2 + (mm)) * 16) * ldc + (bj) * HALF)
#define ER_LOAD(k, buf) do { _Pragma("unroll") for (int mm = 0; mm < 2; ++mm) _Pragma("unroll") for (int bj = 0; bj < 2; ++bj) { \
            if constexpr (BASE_F32) { const float* p = (const float*)base + ER_OFF(k, mm, bj); bf[buf][mm][bj][0] = *(const f32x4*)p; bf[buf][mm][bj][1] = *(const f32x4*)(p + 4); } \
            else { bh[buf][mm][bj] = *(const u32x4*)((const bf16_t*)base + ER_OFF(k, mm, bj)); } } } while (0)
#define ER_STORE(k, buf) do { _Pragma("unroll") for (int mm = 0; mm < 2; ++mm) { float sq = 0.f; _Pragma("unroll") for (int bj = 0; bj < 2; ++bj) { f32x4 v0, v1; \
            if constexpr (BASE_F32) { v0 = bf[buf][mm][bj][0]; v1 = bf[buf][mm][bj][1]; } \
            else { const u32x4 q = bh[buf][mm][bj]; v0 = (f32x4){__builtin_bit_cast(float, q.x << 16), __builtin_bit_cast(float, q.x & 0xffff0000u), __builtin_bit_cast(float, q.y << 16), __builtin_bit_cast(float, q.y & 0xffff0000u)}; \
                   v1 = (f32x4){__builtin_bit_cast(float, q.z << 16), __builtin_bit_cast(float, q.z & 0xffff0000u), __builtin_bit_cast(float, q.w << 16), __builtin_bit_cast(float, q.w & 0xffff0000u)}; } \
            v0 = v0 + acc[(k) >> 1][bj][((k) & 1) * 2 + mm][0]; v1 = v1 + acc[(k) >> 1][bj][((k) & 1) * 2 + mm][1]; \
            if constexpr (SSQW) sq += ((v0[0] * v0[0] + v0[1] * v0[1]) + (v0[2] * v0[2] + v0[3] * v0[3])) + ((v1[0] * v1[0] + v1[1] * v1[1]) + (v1[2] * v1[2] + v1[3] * v1[3])); \
            if constexpr (OUT_F32) { float* p = (float*)out + ER_OFF(k, mm, bj); *(f32x4*)p = v0; *(f32x4*)(p + 4) = v1; } \
            else { u32x4 w; w.x = cvt_pk_bf16(v0[0], v0[1]); w.y = cvt_pk_bf16(v0[2], v0[3]); w.z = cvt_pk_bf16(v1[0], v1[1]); w.w = cvt_pk_bf16(v1[2], v1[3]); *(u32x4*)((bf16_t*)out + ER_OFF(k, mm, bj)) = w; } } \
            if constexpr (SSQW) { sq += __shfl_xor(sq, 16); sq += __shfl_xor(sq, 32); if (fq == 0) ssq[(size_t)(row0 + ((k) >> 1) * HALF + (((k) & 1) * 2 + mm) * 16) * 16 + u.pn * 4 + wc] = sq; } } } while (0)
        ER_LOAD(0, 0);
        asm volatile("" ::: "memory");
        ER_LOAD(1, 1);
        asm volatile("" ::: "memory");
        ER_STORE(0, 0);
        asm volatile("" ::: "memory");
        ER_LOAD(2, 0);
        asm volatile("" ::: "memory");
        ER_STORE(1, 1);
        asm volatile("" ::: "memory");
        ER_LOAD(3, 1);
        asm volatile("" ::: "memory");
        ER_STORE(2, 0);
        asm volatile("" ::: "memory");
        ER_STORE(3, 1);
#undef ER_OFF
#undef ER_LOAD
#undef ER_STORE
    }
};
struct EpiSwiGLU {
    static constexpr bool PERM = true, AFTER_DRAIN = false;
    bf16_t* O; int ldc; RowScale rsc;
    __device__ __forceinline__ static float silu_mul(float g, float up) { return g * __builtin_amdgcn_rcpf(1.0f + __expf(-g)) * up; }
    __device__ __forceinline__ void operator()(const f32x4 (&acc)[2][2][4][2], const Unit& u, int wr, int wc, int fr, int fq) const {
        const int row0 = u.pm * BM + wr * 64 + fr, col0 = u.pn * HALF + wc * 32 + 8 * fq;
#pragma unroll
        for (int ai = 0; ai < 2; ++ai)
#pragma unroll
            for (int m = 0; m < 4; ++m) { bf16_t* rowp = O + (size_t)(row0 + ai * HALF + m * 16) * ldc + col0;
                const float rs = rsc.get(u.pm, ai * HALF + wr * 64 + m * 16 + fr);
                const f32x4 g0 = acc[ai][0][m][0] * rs, g1 = acc[ai][0][m][1] * rs, u0 = acc[ai][1][m][0] * rs, u1 = acc[ai][1][m][1] * rs;
                u32x4 w; w.x = cvt_pk_bf16(silu_mul(g0[0], u0[0]), silu_mul(g0[1], u0[1])); w.y = cvt_pk_bf16(silu_mul(g0[2], u0[2]), silu_mul(g0[3], u0[3]));
                w.z = cvt_pk_bf16(silu_mul(g1[0], u1[0]), silu_mul(g1[1], u1[1])); w.w = cvt_pk_bf16(silu_mul(g1[2], u1[2]), silu_mul(g1[3], u1[3]));
                *(u32x4*)rowp = w; }
    }
};

template <class Epi, class Sched, bool ALIGN_EPI = false, bool SP2 = false>
__device__ __forceinline__ void gemm_phase(PG8_LAS unsigned char* lds, const Gemm g, const Sched& S, const Epi& E) {
    const int tid = threadIdx.x, wid = __builtin_amdgcn_readfirstlane(tid >> 6), lane = tid & 63, wr = wid >> 2, wc = wid & 3, fr = lane & 15, fq = lane >> 4;
    const int K = g.K, nt = K / BK;
    unsigned voffA[2], voffB[2];
#pragma unroll
    for (int i = 0; i < 2; ++i) { int R, C; stage_rc(tid * 16 + i * 8192, R, C); const int Rb = Epi::PERM ? ((R & ~31) + perm32(R & 31)) : R;
        voffA[i] = (unsigned)(R * K + C) * 2u; voffB[i] = (unsigned)(Rb * K + C) * 2u; }
    const size_t kstep = (size_t)(BK * 2);
    const size_t hstep = (size_t)HALF * K * 2;
    const size_t tstep = 2 * hstep;
    const unsigned ldsw = (unsigned)wid * 1024u;
    const int aoff = lds_byte(wr * 64 + fr, fq * 8), boff = lds_byte(wc * 32 + fr, fq * 8);
#define PG8_SA(b, h) (((b) * 2 + (h)) * HTB)
#define PG8_SB(b, h) ((4 + (b) * 2 + (h)) * HTB)
#define PG8_STAGE(bufoff, gbase, voff) do { _Pragma("unroll") for (int _i = 0; _i < 2; ++_i) \
        __builtin_amdgcn_global_load_lds((const unsigned*)((const char*)(gbase) + (voff)[_i]), (PG8_LAS unsigned*)(lds + (bufoff) + ldsw + _i * 8192), 16, 0, 0); } while (0)
#define PG8_LDA(dst, b, h) do { _Pragma("unroll") for (int m = 0; m < 4; ++m) _Pragma("unroll") for (int k = 0; k < 2; ++k) dst[m][k] = *(const PG8_LAS bf16x8*)(lds + PG8_SA(b, h) + aoff + m * 2048 + k * 1024); } while (0)
#define PG8_LDB(dst, b, h) do { _Pragma("unroll") for (int n = 0; n < 2; ++n) _Pragma("unroll") for (int k = 0; k < 2; ++k) dst[n][k] = *(const PG8_LAS bf16x8*)(lds + PG8_SB(b, h) + boff + n * 2048 + k * 1024); } while (0)
#define PG8_MMA(ai, bj, At, Bt) do { __builtin_amdgcn_s_setprio(1); _Pragma("unroll") for (int m = 0; m < 4; ++m) _Pragma("unroll") for (int n = 0; n < 2; ++n) _Pragma("unroll") for (int k = 0; k < 2; ++k) \
        acc[ai][bj][m][n] = __builtin_amdgcn_mfma_f32_16x16x32_bf16(Bt[n][k], At[m][k], acc[ai][bj][m][n], 0, 0, 0); __builtin_amdgcn_s_setprio(0); } while (0)
#define PG8_WAIT_V(n) asm volatile("s_waitcnt vmcnt(" #n ")" ::: "memory")
#define PG8_WAIT_L(n) asm volatile("s_waitcnt lgkmcnt(" #n ")" ::: "memory")
#define PG8_BAR __builtin_amdgcn_s_barrier()
#define PG8_SCHED __builtin_amdgcn_sched_barrier(0)
    Unit cur, nxt; int ui = 0;
    if (!S.next(0, cur)) return;
    f32x4 acc[2][2][4][2];
#pragma unroll
    for (int a = 0; a < 2; ++a)
#pragma unroll
        for (int b = 0; b < 2; ++b)
#pragma unroll
            for (int m = 0; m < 4; ++m)
#pragma unroll
                for (int n = 0; n < 2; ++n) acc[a][b][m][n] = (f32x4){0.f, 0.f, 0.f, 0.f};
    bf16x8 At[4][2], B0[2][2], B1[2][2];
    const char* cA = (const char*)g.A + (size_t)cur.pm * tstep; const char* cB = (const char*)g.Bt + (size_t)cur.pn * tstep;
    S.a_ready(cur);
    if constexpr (SP2) {
        PG8_STAGE(PG8_SB(0, 0), cB, voffB); PG8_STAGE(PG8_SB(0, 1), cB + hstep, voffB); PG8_STAGE(PG8_SA(0, 0), cA, voffA); PG8_STAGE(PG8_SA(0, 1), cA + hstep, voffA);
        if (wr == 1) PG8_BAR;
        PG8_WAIT_V(2); PG8_BAR;
        PG8_STAGE(PG8_SB(1, 0), cB + kstep, voffB); PG8_STAGE(PG8_SA(1, 0), cA + kstep, voffA); PG8_STAGE(PG8_SB(1, 1), cB + hstep + kstep, voffB);
        PG8_WAIT_V(6); PG8_BAR;
    } else {
        PG8_STAGE(PG8_SB(0, 0), cB, voffB); PG8_STAGE(PG8_SA(0, 0), cA, voffA); PG8_STAGE(PG8_SB(0, 1), cB + hstep, voffB); PG8_STAGE(PG8_SA(0, 1), cA + hstep, voffA);
        if (wr == 1) PG8_BAR;
        PG8_WAIT_V(4); PG8_BAR;
        PG8_STAGE(PG8_SB(1, 0), cB + kstep, voffB); PG8_STAGE(PG8_SA(1, 0), cA + kstep, voffA); PG8_STAGE(PG8_SB(1, 1), cB + hstep + kstep, voffB);
        PG8_WAIT_V(6); PG8_BAR;
    }
    for (;;) {
        const bool has_next = S.next(ui + 1, nxt);
        const char* nA = has_next ? (const char*)g.A + (size_t)nxt.pm * tstep : cA; const char* nB = has_next ? (const char*)g.Bt + (size_t)nxt.pn * tstep : cB;
        for (int t = 0; t < nt; t += 2) {
            const bool last = (t == nt - 2);
            const char* a1 = cA + (size_t)(t + 1) * kstep;
            const char* a2 = last ? nA : cA + (size_t)(t + 2) * kstep; const char* b2 = last ? nB : cB + (size_t)(t + 2) * kstep;
            const char* a3 = a2 + kstep; const char* b3 = b2 + kstep;
            if (last && has_next) S.a_ready(nxt);
            if constexpr (SP2) {
            PG8_LDB(B0, 0, 0); PG8_LDB(B1, 0, 1); PG8_SCHED; PG8_LDA(At, 0, 0); PG8_STAGE(PG8_SA(1, 1), a1 + hstep, voffA);
            PG8_WAIT_V(8); PG8_WAIT_L(0); PG8_BAR; PG8_MMA(0, 0, At, B0); PG8_MMA(0, 1, At, B1); PG8_BAR; PG8_SCHED;
            PG8_LDA(At, 0, 1); PG8_STAGE(PG8_SB(0, 0), b2, voffB); PG8_STAGE(PG8_SB(0, 1), b2 + hstep, voffB); PG8_STAGE(PG8_SA(0, 0), a2, voffA);
            PG8_WAIT_V(8); PG8_WAIT_L(0); PG8_BAR; PG8_MMA(1, 0, At, B0); PG8_MMA(1, 1, At, B1); PG8_BAR; PG8_SCHED;
            PG8_LDB(B0, 1, 0); PG8_LDB(B1, 1, 1); PG8_SCHED; PG8_LDA(At, 1, 0); PG8_STAGE(PG8_SA(0, 1), a2 + hstep, voffA);
            PG8_WAIT_V(8); PG8_WAIT_L(0); PG8_BAR; PG8_MMA(0, 0, At, B0); PG8_MMA(0, 1, At, B1); PG8_BAR; PG8_SCHED;
            PG8_LDA(At, 1, 1); PG8_STAGE(PG8_SB(1, 0), b3, voffB); PG8_STAGE(PG8_SB(1, 1), b3 + hstep, voffB); PG8_STAGE(PG8_SA(1, 0), a3, voffA);
            PG8_WAIT_V(8); PG8_WAIT_L(0); PG8_BAR; PG8_MMA(1, 0, At, B0); PG8_MMA(1, 1, At, B1); PG8_BAR; PG8_SCHED;
            } else {
            PG8_LDB(B0, 0, 0); PG8_SCHED; PG8_LDA(At, 0, 0); PG8_STAGE(PG8_SA(1, 1), a1 + hstep, voffA);
            PG8_WAIT_L(8); PG8_BAR; PG8_WAIT_L(0); PG8_MMA(0, 0, At, B0); PG8_BAR; PG8_SCHED;
            PG8_LDB(B1, 0, 1); PG8_STAGE(PG8_SB(0, 0), b2, voffB);
            PG8_BAR; PG8_WAIT_L(0); PG8_MMA(0, 1, At, B1); PG8_BAR;
            PG8_LDA(At, 0, 1); PG8_STAGE(PG8_SA(0, 0), a2, voffA);
            PG8_BAR; PG8_WAIT_L(0); PG8_MMA(1, 0, At, B0); PG8_BAR; PG8_SCHED;
            PG8_STAGE(PG8_SB(0, 1), b2 + hstep, voffB);
            PG8_WAIT_V(6); PG8_BAR; PG8_MMA(1, 1, At, B1); PG8_BAR;
            PG8_LDB(B0, 1, 0); PG8_SCHED; PG8_LDA(At, 1, 0); PG8_STAGE(PG8_SA(0, 1), a2 + hstep, voffA);
            PG8_WAIT_L(8); PG8_BAR; PG8_WAIT_L(0); PG8_MMA(0, 0, At, B0); PG8_BAR; PG8_SCHED;
            PG8_LDB(B1, 1, 1); PG8_STAGE(PG8_SB(1, 0), b3, voffB);
            PG8_BAR; PG8_WAIT_L(0); PG8_MMA(0, 1, At, B1); PG8_BAR;
            PG8_LDA(At, 1, 1); PG8_STAGE(PG8_SA(1, 0), a3, voffA);
            PG8_BAR; PG8_WAIT_L(0); PG8_MMA(1, 0, At, B0); PG8_BAR; PG8_SCHED;
            PG8_STAGE(PG8_SB(1, 1), b3 + hstep, voffB);
            PG8_WAIT_V(6); PG8_BAR; PG8_MMA(1, 1, At, B1); PG8_BAR;
            }
        }
        if constexpr (ALIGN_EPI) { if (wr == 0) PG8_BAR; }
        if constexpr (!Epi::AFTER_DRAIN) { E(acc, cur, wr, wc, fr, fq); S.done(cur); }
        if (!has_next) break;
#pragma unroll
        for (int a = 0; a < 2; ++a)
#pragma unroll
            for (int b = 0; b < 2; ++b)
#pragma unroll
                for (int m = 0; m < 4; ++m)
#pragma unroll
                    for (int n = 0; n < 2; ++n) acc[a][b][m][n] = (f32x4){0.f, 0.f, 0.f, 0.f};
        cur = nxt; cA = nA; cB = nB; ++ui;
        if constexpr (ALIGN_EPI) { if (wr == 1) PG8_BAR; }
    }
    PG8_WAIT_V(0);
    if constexpr (!ALIGN_EPI) { if (wr == 0) PG8_BAR; }
    PG8_BAR;
    if constexpr (Epi::AFTER_DRAIN) { E.fused(acc, cur, wr, wc, fr, fq, lds, wid, lane); S.done(cur); }
#undef PG8_SA
#undef PG8_SB
#undef PG8_STAGE
#undef PG8_LDA
#undef PG8_LDB
#undef PG8_MMA
#undef PG8_WAIT_V
#undef PG8_WAIT_L
#undef PG8_BAR
#undef PG8_SCHED
}
}

constexpr int NWAVES = 8, NTHR = 512;
constexpr int BATCH = 16, SEQ = 2048, D = 1024, M = BATCH * SEQ;
constexpr int EVEN_IN = 2560, DFF = 2816, NGU = 2 * DFF;
constexpr int ODD_IN = 960, ODD_IN_P = 1024, POOLW = 256, QLORA = 384, KVLORA = 256;
constexpr int NH = 6, QKD = 192, NQ = NH * QKD  , NQ_P = 1280, NKV = NH * 256  ;
constexpr float EPS = 1e-6f;
constexpr float QSCALE = 0.07216878364870322f * 1.4426950408889634f;

constexpr size_t MiB = 1u << 20;
constexpr int XCD_BAR_WORDS_C = 3456;
constexpr size_t WS_WIN0 = 1 * MiB;
constexpr size_t WS_WOUT0 = WS_WIN0 + (size_t)EVEN_IN * D * 2;
constexpr size_t WS_WGU = WS_WOUT0 + (size_t)D * D * 2;
constexpr size_t WS_WDN = WS_WGU + 2 * (size_t)NGU * D * 2;
constexpr size_t WS_WIN1 = WS_WDN + 2 * (size_t)D * DFF * 2;
constexpr size_t WS_WQB = WS_WIN1 + (size_t)ODD_IN_P * D * 2;
constexpr size_t WS_WKVB = WS_WQB + (size_t)NQ_P * QLORA * 2;
constexpr size_t WS_WPOOL = WS_WKVB + (size_t)NKV * KVLORA * 2;
constexpr size_t WS_WOUT1 = WS_WPOOL + (size_t)POOLW * POOLW * 2;
constexpr size_t WS_COS = WS_WOUT1 + (size_t)D * D * 2;
constexpr size_t WS_SIN = WS_COS + (size_t)M * 32 * 4;
constexpr size_t WS_WEND = WS_SIN + (size_t)M * 32 * 4;
static_assert(XCD_BAR_WORDS_C * 4 <= 16384 && WS_WEND <= 56 * MiB, "weights region");
constexpr size_t WS_MIX = 56 * MiB;
constexpr size_t WS_XN = 120 * MiB;
constexpr size_t WS_R = 184 * MiB;
constexpr size_t WS_PROJ0 = WS_R;
constexpr size_t WS_ACT = WS_R;
constexpr size_t WS_PROJ1 = WS_R;
constexpr size_t WS_QN = WS_R + 64 * MiB;
constexpr size_t WS_KVN = WS_R + 88 * MiB;
constexpr size_t WS_POOLED = WS_R + 104 * MiB;
constexpr size_t WS_KROPE = WS_R + 120 * MiB;
constexpr size_t WS_QRAW = WS_R + 124 * MiB;
constexpr size_t WS_XB = WS_R + 196 * MiB;
constexpr size_t WS_KB = WS_XN;
constexpr size_t WS_VT = 192 * MiB;
constexpr size_t WS_SSQ = WS_XB + 64 * MiB;
constexpr size_t WS_END = WS_SSQ + 2 * MiB;
static_assert(WS_END <= 512 * MiB, "d_ws map");

constexpr int RSTAB_OFF = 131072 + 64;
constexpr int LDS_BYTES = 136192;

#define LAS __attribute__((address_space(3)))
typedef unsigned short bf16;
typedef unsigned v4u __attribute__((ext_vector_type(4)));
typedef unsigned v2u __attribute__((ext_vector_type(2)));
typedef float f32x4 __attribute__((ext_vector_type(4)));
typedef float f32x16 __attribute__((ext_vector_type(16)));
typedef short bf16x8 __attribute__((ext_vector_type(8)));
typedef short s16x4 __attribute__((ext_vector_type(4)));
#define LDS_WAIT() asm volatile("s_waitcnt lgkmcnt(0)" ::: "memory")
__device__ __forceinline__ unsigned f2bf(float f) { unsigned u = __builtin_bit_cast(unsigned, f); return (u + 0x7fffu + ((u >> 16) & 1u)) >> 16; }
__device__ __forceinline__ unsigned pk2(float lo, float hi) { return pg8::cvt_pk_bf16(lo, hi); }
__device__ __forceinline__ float bflo(unsigned w) { return __builtin_bit_cast(float, w << 16); }
__device__ __forceinline__ float bfhi(unsigned w) { return __builtin_bit_cast(float, w & 0xffff0000u); }
__device__ __forceinline__ float wave_sum(float v) {
#pragma unroll
    for (int o = 1; o < 64; o <<= 1) v += __shfl_xor(v, o);
    return v;
}

struct Frame {
    LAS unsigned char* lds;
    int tid, lane, wave, G, bid;
};

__device__ __forceinline__ void tr_item(const float* W, int ldn, int k0, int n0, bf16* WT, int ldk, int drow0, int dk0, LAS float* scr, int lane, const float* gk = nullptr) {
#pragma unroll 8
    for (int i = 0; i < 32; ++i) { const int kk = 2 * i + (lane >> 5); scr[kk * 33 + (lane & 31)] = W[(size_t)(k0 + kk) * ldn + n0 + (lane & 31)] * (gk ? gk[k0 + kk] : 1.f); }
    LDS_WAIT(); asm volatile("" ::: "memory");
    const int c = lane & 7;
#pragma unroll
    for (int j = 0; j < 4; ++j) { const int n = (lane >> 3) + 8 * j; const LAS float* s = scr + (8 * c) * 33 + n;
        v4u o; o.x = pk2(s[0 * 33], s[1 * 33]); o.y = pk2(s[2 * 33], s[3 * 33]); o.z = pk2(s[4 * 33], s[5 * 33]); o.w = pk2(s[6 * 33], s[7 * 33]);
        *(v4u*)(WT + (size_t)(drow0 + n) * ldk + dk0 + 8 * c) = o; }
    LDS_WAIT(); asm volatile("" ::: "memory");
}
template <int MODE> __device__ __forceinline__ void tr_matrix(const Frame& F, const float* W, int K, int N, bf16* WT, LAS float* scr, const float* gk = nullptr) {
    const int nnb = N / 32, nit = (K / 64) * nnb; const int gw = F.bid * NWAVES + F.wave, NGW = F.G * NWAVES;
    for (int it = gw; it < nit; it += NGW) { const int kb = it / nnb, nb = it % nnb, n0 = 32 * nb;
        const int dr = MODE == 0 ? n0 : (256 * (n0 >> 7) + (n0 & 127) + (MODE == 2 ? 128 : 0));
        tr_item(W, N, 64 * kb, n0, WT, K, dr, 64 * kb, scr, F.lane, gk); }
}
template <bool IN_F32> __device__ __forceinline__ void rms_rows(const Frame& F, const void* Xv, const float* g, bf16* XN) {
    const int gw = F.bid * NWAVES + F.wave, NGW = F.G * NWAVES;
    f32x4 gv[4];
#pragma unroll
    for (int j = 0; j < 4; ++j) gv[j] = ((const f32x4*)g)[F.lane + 64 * j];
    for (int m = gw; m < M; m += NGW) {
        f32x4 v[4]; float s = 0.f;
        if constexpr (IN_F32) { const f32x4* xr = (const f32x4*)((const float*)Xv + (size_t)m * D) + F.lane;
#pragma unroll
            for (int j = 0; j < 4; ++j) v[j] = xr[64 * j]; }
        else { const v2u* xr = (const v2u*)((const bf16*)Xv + (size_t)m * D) + F.lane;
#pragma unroll
            for (int j = 0; j < 4; ++j) { const v2u q = xr[64 * j]; v[j] = (f32x4){bflo(q.x), bfhi(q.x), bflo(q.y), bfhi(q.y)}; } }
#pragma unroll
        for (int j = 0; j < 4; ++j) s += (v[j].x * v[j].x + v[j].y * v[j].y) + (v[j].z * v[j].z + v[j].w * v[j].w);
        const float rstd = 1.0f / sqrtf(wave_sum(s) * (1.f / D) + EPS);
        unsigned long long* o8 = (unsigned long long*)(XN + (size_t)m * D) + F.lane;
#pragma unroll
        for (int j = 0; j < 4; ++j) { const f32x4 y = v[j] * rstd * gv[j]; o8[64 * j] = (unsigned long long)pk2(y.x, y.y) | ((unsigned long long)pk2(y.z, y.w) << 32); }
    }
}
struct Ptrs {
    const float* in[23]; const int* pos; float* out; unsigned char* ws;
};
__device__ __forceinline__ void p0_prologue(const Frame& F, const Ptrs& P) {
    LAS float* scr = (LAS float*)(F.lds + F.wave * 16384);
    unsigned char* ws = P.ws;
    tr_matrix<0>(F, P.in[4], D, EVEN_IN, (bf16*)(ws + WS_WIN0), scr);
    tr_matrix<0>(F, P.in[9], D, D, (bf16*)(ws + WS_WOUT0), scr);
    for (int l = 0; l < 2; ++l) {
        tr_matrix<1>(F, P.in[20] + (size_t)l * D * DFF, D, DFF, (bf16*)(ws + WS_WGU) + (size_t)l * NGU * D, scr, P.in[3] + l * D);
        tr_matrix<2>(F, P.in[21] + (size_t)l * D * DFF, D, DFF, (bf16*)(ws + WS_WGU) + (size_t)l * NGU * D, scr, P.in[3] + l * D);
        tr_matrix<0>(F, P.in[22] + (size_t)l * DFF * D, DFF, D, (bf16*)(ws + WS_WDN) + (size_t)l * D * DFF, scr);
    }
    tr_matrix<0>(F, P.in[10], D, ODD_IN, (bf16*)(ws + WS_WIN1), scr, P.in[2] + D);
    tr_matrix<0>(F, P.in[14], QLORA, NQ, (bf16*)(ws + WS_WQB), scr);
    tr_matrix<0>(F, P.in[16], KVLORA, NKV, (bf16*)(ws + WS_WKVB), scr);
    tr_matrix<0>(F, P.in[19], D, D, (bf16*)(ws + WS_WOUT1), scr);
    const int gw = F.bid * NWAVES + F.wave, NGW = F.G * NWAVES;
    for (int it = gw; it < 8; it += NGW) { const int g = it >> 1, nb = it & 1;
        tr_item(P.in[11] + g * 4096, 64, 0, 32 * nb, (bf16*)(ws + WS_WPOOL), POOLW, g * 64 + 32 * nb, g * 64, scr, F.lane); }
    const int gt = F.bid * NTHR + F.tid, NGT = F.G * NTHR;
    const v4u z4 = {0u, 0u, 0u, 0u};
    { v4u* p = (v4u*)((bf16*)(ws + WS_WIN1) + (size_t)ODD_IN * D); for (int i = gt; i < (ODD_IN_P - ODD_IN) * D / 8; i += NGT) p[i] = z4; }
    { v4u* p = (v4u*)((bf16*)(ws + WS_WQB) + (size_t)NQ * QLORA); for (int i = gt; i < (NQ_P - NQ) * QLORA / 8; i += NGT) p[i] = z4; }
    { v4u* p = (v4u*)(ws + WS_WPOOL); for (int i = gt; i < POOLW * POOLW / 8; i += NGT) { const int row = i >> 5, kblk = (i & 31) >> 3; if (kblk != (row >> 6)) p[i] = z4; } }
    { float* C = (float*)(ws + WS_COS); float* S = (float*)(ws + WS_SIN);
      for (int i = gt; i < M * 32; i += NGT) { const int m = i >> 5, f = i & 31;
          const float inv = powf(10000.0f, -(float)(2 * f) / 64.0f); const float ang = (float)P.pos[m] * inv;
          const double rev = (double)ang * 0.15915494309189535; const float fr = (float)(rev - rint(rev));
          C[i] = __builtin_amdgcn_cosf(fr); S[i] = __builtin_amdgcn_sinf(fr); } }
    rms_rows<true>(F, P.in[0], P.in[2], (bf16*)(ws + WS_XN));
}

__device__ __forceinline__ void p2_even_mixer(const Frame& F, const Ptrs& P) {
    constexpr int PITCH = 136;
    LAS bf16* sW = (LAS bf16*)(F.lds);
    LAS bf16* sV = (LAS bf16*)(F.lds + 128 * PITCH * 2);
    const bf16* PROJ = (const bf16*)(P.ws + WS_PROJ0); bf16* MIX = (bf16*)(P.ws + WS_MIX);
    const float* ln_g = P.in[5]; const float* w_s = P.in[6]; const float* b_s = P.in[7]; const float* conv_w = P.in[8];
    const int tid = F.tid, lane = F.lane, w = F.wave;
    int hcur = -1;
    for (int u = F.bid; u < 1536; u += F.G) {
        if (u < 1024) {
            const int b = u >> 6, n = (u >> 2) & 15, h = u & 3; const int tok0 = b * SEQ + n * 128;
            v4u uqv[4];
            { const size_t tokl = (size_t)(tok0 + 16 * w + (lane & 15)); const int q4 = lane >> 4;
#pragma unroll
              for (int e = 0; e < 4; ++e) uqv[e] = *(const v4u*)(PROJ + tokl * EVEN_IN + h * 128 + 32 * e + 16 * (q4 & 1) + 8 * (q4 >> 1)); }
            if (h != hcur) {
                hcur = h;
                const int t = tid >> 2, s0 = (tid & 3) * 32; const f32x4* src = (const f32x4*)(w_s + ((size_t)h * 128 + t) * 128 + s0);
#pragma unroll
                for (int i = 0; i < 4; ++i) { f32x4 a = src[2 * i], c = src[2 * i + 1]; const int s = s0 + 8 * i;
                    v4u o; o.x = pk2(s + 0 <= t ? a.x : 0.f, s + 1 <= t ? a.y : 0.f); o.y = pk2(s + 2 <= t ? a.z : 0.f, s + 3 <= t ? a.w : 0.f);
                    o.z = pk2(s + 4 <= t ? c.x : 0.f, s + 5 <= t ? c.y : 0.f); o.w = pk2(s + 6 <= t ? c.z : 0.f, s + 7 <= t ? c.w : 0.f);
                    *(LAS v4u*)(sW + t * PITCH + s) = o; }
            }
            {
                const int s = tid >> 2, d0 = (tid & 3) * 32; const v4u* src = (const v4u*)(PROJ + (size_t)(tok0 + s) * EVEN_IN + 512 + h * 128 + d0);
                float v[32]; float sum = 0.f;
#pragma unroll
                for (int i = 0; i < 4; ++i) { const v4u q = src[i];
                    v[8 * i + 0] = bflo(q.x); v[8 * i + 1] = bfhi(q.x); v[8 * i + 2] = bflo(q.y); v[8 * i + 3] = bfhi(q.y);
                    v[8 * i + 4] = bflo(q.z); v[8 * i + 5] = bfhi(q.z); v[8 * i + 6] = bflo(q.w); v[8 * i + 7] = bfhi(q.w); }
#pragma unroll
                for (int i = 0; i < 32; ++i) sum += v[i];
                sum += __shfl_xor(sum, 1); sum += __shfl_xor(sum, 2);
                const float mean = sum * (1.f / 128.f); float sq = 0.f;
#pragma unroll
                for (int i = 0; i < 32; ++i) { v[i] -= mean; sq += v[i] * v[i]; }
                sq += __shfl_xor(sq, 1); sq += __shfl_xor(sq, 2);
                const float rstd = 1.0f / sqrtf(sq * (1.f / 128.f) + EPS);
                const f32x4* gp = (const f32x4*)(ln_g + h * 128 + d0);
#pragma unroll
                for (int i = 0; i < 8; ++i) { const f32x4 g = gp[i];
                    sV[(d0 + 4 * i + 0) * PITCH + s] = (bf16)f2bf(v[4 * i + 0] * rstd * g.x); sV[(d0 + 4 * i + 1) * PITCH + s] = (bf16)f2bf(v[4 * i + 1] * rstd * g.y);
                    sV[(d0 + 4 * i + 2) * PITCH + s] = (bf16)f2bf(v[4 * i + 2] * rstd * g.z); sV[(d0 + 4 * i + 3) * PITCH + s] = (bf16)f2bf(v[4 * i + 3] * rstd * g.w); }
            }
            __syncthreads();
            f32x4 acc[8];
#pragma unroll
            for (int dt = 0; dt < 8; ++dt) acc[dt] = (f32x4){0.f, 0.f, 0.f, 0.f};
            const int nk = (w >> 1) + 1;
            for (int ks = 0; ks < nk; ++ks) {
                const bf16x8 bw = *(const LAS bf16x8*)(sW + (16 * w + (lane & 15)) * PITCH + ks * 32 + (lane >> 4) * 8);
#pragma unroll
                for (int dt = 0; dt < 8; ++dt) { const bf16x8 av = *(const LAS bf16x8*)(sV + (16 * dt + (lane & 15)) * PITCH + ks * 32 + (lane >> 4) * 8);
                    acc[dt] = __builtin_amdgcn_mfma_f32_16x16x32_bf16(av, bw, acc[dt], 0, 0, 0); }
            }
            { const int t = 16 * w + (lane & 15); const float bias = b_s[h * 128 + t]; const size_t tok = (size_t)(tok0 + t);
              const int q4 = lane >> 4, odd = q4 & 1;
#pragma unroll
              for (int e = 0; e < 4; ++e) {
                  const f32x4 keep = odd ? acc[2 * e + 1] : acc[2 * e], send = odd ? acc[2 * e] : acc[2 * e + 1];
                  f32x4 recv;
#pragma unroll
                  for (int i = 0; i < 4; ++i) recv[i] = __shfl_xor(send[i], 16);
                  const f32x4 lo = odd ? recv : keep, hi = odd ? keep : recv;
                  const v4u uq = uqv[e];
                  v4u o; o.x = pk2(bflo(uq.x) * (lo[0] + bias), bfhi(uq.x) * (lo[1] + bias)); o.y = pk2(bflo(uq.y) * (lo[2] + bias), bfhi(uq.y) * (lo[3] + bias));
                  o.z = pk2(bflo(uq.z) * (hi[0] + bias), bfhi(uq.z) * (hi[1] + bias)); o.w = pk2(bflo(uq.w) * (hi[2] + bias), bfhi(uq.w) * (hi[3] + bias));
                  *(v4u*)(MIX + tok * D + h * 128 + 32 * e + 16 * odd + 8 * (q4 >> 1)) = o; } }
            __syncthreads();
        } else {
            const int cu = u - 1024, c0 = (tid & 63) * 8, tg = tid >> 6; const int tokb = cu * 64 + tg * 8; const int sb = tokb & (SEQ - 1);
            float w0[8], w1[8], w2[8];
#pragma unroll
            for (int e = 0; e < 2; ++e) { const f32x4 a = *(const f32x4*)(conv_w + c0 + 4 * e), c = *(const f32x4*)(conv_w + 512 + c0 + 4 * e), d = *(const f32x4*)(conv_w + 1024 + c0 + 4 * e);
#pragma unroll
                for (int k = 0; k < 4; ++k) { w0[4 * e + k] = a[k]; w1[4 * e + k] = c[k]; w2[4 * e + k] = d[k]; } }
            float zp2[8], zp1[8];
#pragma unroll
            for (int k = 0; k < 8; ++k) { zp2[k] = 0.f; zp1[k] = 0.f; }
#pragma unroll
            for (int i = -2; i < 8; ++i) {
                if (i < 0 && sb + i < 0) continue;
                const bf16* row = PROJ + (size_t)(tokb + i) * EVEN_IN;
                const v4u cq = *(const v4u*)(row + 1536 + c0), hq = *(const v4u*)(row + 2048 + c0);
                float z[8];
                z[0] = bflo(cq.x) * bflo(hq.x); z[1] = bfhi(cq.x) * bfhi(hq.x); z[2] = bflo(cq.y) * bflo(hq.y); z[3] = bfhi(cq.y) * bfhi(hq.y);
                z[4] = bflo(cq.z) * bflo(hq.z); z[5] = bfhi(cq.z) * bfhi(hq.z); z[6] = bflo(cq.w) * bflo(hq.w); z[7] = bfhi(cq.w) * bfhi(hq.w);
                if (i >= 0) { const v4u bq = *(const v4u*)(row + 1024 + c0);
                    float bg[8]; bg[0] = bflo(bq.x); bg[1] = bfhi(bq.x); bg[2] = bflo(bq.y); bg[3] = bfhi(bq.y); bg[4] = bflo(bq.z); bg[5] = bfhi(bq.z); bg[6] = bflo(bq.w); bg[7] = bfhi(bq.w);
                    float y[8];
#pragma unroll
                    for (int k = 0; k < 8; ++k) y[k] = bg[k] * (w0[k] * zp2[k] + w1[k] * zp1[k] + w2[k] * z[k]);
                    v4u o; o.x = pk2(y[0], y[1]); o.y = pk2(y[2], y[3]); o.z = pk2(y[4], y[5]); o.w = pk2(y[6], y[7]);
                    *(v4u*)(MIX + (size_t)(tokb + i) * D + 512 + c0) = o; }
#pragma unroll
                for (int k = 0; k < 8; ++k) { zp2[k] = zp1[k]; zp1[k] = z[k]; }
            }
        }
    }
}

__device__ __forceinline__ void p9_token_ops(const Frame& F, const Ptrs& P) {
    const bf16* PROJ = (const bf16*)(P.ws + WS_PROJ1);
    bf16* QN = (bf16*)(P.ws + WS_QN); bf16* KVN = (bf16*)(P.ws + WS_KVN); bf16* PL = (bf16*)(P.ws + WS_POOLED); bf16* KR = (bf16*)(P.ws + WS_KROPE);
    const int lane = F.lane; const int gw = F.bid * NWAVES + F.wave, NGW = F.G * NWAVES;
    const int j16 = lane & 15;
    f32x4 gqv[6], gkvv[4];
#pragma unroll
    for (int k = 0; k < 6; ++k) gqv[k] = *(const f32x4*)(P.in[13] + 24 * j16 + 4 * k);
#pragma unroll
    for (int k = 0; k < 4; ++k) gkvv[k] = *(const f32x4*)(P.in[15] + 16 * j16 + 4 * k);
    const int lg = lane >> 4;
    for (int grp = gw; grp < M / 16; grp += NGW) {
        const int m0 = grp * 16; const int s0 = m0 & (SEQ - 1);
        v2u hq[31];
#pragma unroll
        for (int i = 0; i < 31; ++i) { if (i >= 15 || s0 != 0) hq[i] = *(const v2u*)(PROJ + (size_t)(m0 + i - 15) * ODD_IN_P + 4 * lane); else hq[i] = (v2u){0u, 0u}; }
#pragma unroll 2
        for (int r4 = 0; r4 < 4; ++r4) {
            const int m = m0 + 4 * r4 + (lane >> 4); const bf16* row = PROJ + (size_t)m * ODD_IN_P;
            v4u qv[3], kvv[2];
#pragma unroll
            for (int k = 0; k < 3; ++k) qv[k] = *(const v4u*)(row + 256 + 24 * j16 + 8 * k);
#pragma unroll
            for (int k = 0; k < 2; ++k) kvv[k] = *(const v4u*)(row + 640 + 16 * j16 + 8 * k);
            v4u krv = {0u, 0u, 0u, 0u}; if (j16 < 8) krv = *(const v4u*)(row + 896 + 8 * j16);
            float sq = 0.f, sk = 0.f;
#pragma unroll
            for (int k = 0; k < 3; ++k) { const v4u q = qv[k]; const float a0 = bflo(q.x), a1 = bfhi(q.x), a2 = bflo(q.y), a3 = bfhi(q.y), a4 = bflo(q.z), a5 = bfhi(q.z), a6 = bflo(q.w), a7 = bfhi(q.w);
                sq += ((a0 * a0 + a1 * a1) + (a2 * a2 + a3 * a3)) + ((a4 * a4 + a5 * a5) + (a6 * a6 + a7 * a7)); }
#pragma unroll
            for (int k = 0; k < 2; ++k) { const v4u q = kvv[k]; const float a0 = bflo(q.x), a1 = bfhi(q.x), a2 = bflo(q.y), a3 = bfhi(q.y), a4 = bflo(q.z), a5 = bfhi(q.z), a6 = bflo(q.w), a7 = bfhi(q.w);
                sk += ((a0 * a0 + a1 * a1) + (a2 * a2 + a3 * a3)) + ((a4 * a4 + a5 * a5) + (a6 * a6 + a7 * a7)); }
#pragma unroll
            for (int o = 1; o < 16; o <<= 1) { sq += __shfl_xor(sq, o); sk += __shfl_xor(sk, o); }
            const float rq = 1.0f / sqrtf(sq * (1.f / QLORA) + EPS), rk = 1.0f / sqrtf(sk * (1.f / KVLORA) + EPS);
#pragma unroll
            for (int k = 0; k < 3; ++k) { const v4u q = qv[k]; const f32x4 ga = gqv[2 * k], gb = gqv[2 * k + 1];
                v4u o; o.x = pk2(bflo(q.x) * rq * ga.x, bfhi(q.x) * rq * ga.y); o.y = pk2(bflo(q.y) * rq * ga.z, bfhi(q.y) * rq * ga.w);
                o.z = pk2(bflo(q.z) * rq * gb.x, bfhi(q.z) * rq * gb.y); o.w = pk2(bflo(q.w) * rq * gb.z, bfhi(q.w) * rq * gb.w);
                *(v4u*)(QN + (size_t)m * QLORA + 24 * j16 + 8 * k) = o; }
#pragma unroll
            for (int k = 0; k < 2; ++k) { const v4u q = kvv[k]; const f32x4 ga = gkvv[2 * k], gb = gkvv[2 * k + 1];
                v4u o; o.x = pk2(bflo(q.x) * rk * ga.x, bfhi(q.x) * rk * ga.y); o.y = pk2(bflo(q.y) * rk * ga.z, bfhi(q.y) * rk * ga.w);
                o.z = pk2(bflo(q.z) * rk * gb.x, bfhi(q.z) * rk * gb.y); o.w = pk2(bflo(q.w) * rk * gb.z, bfhi(q.w) * rk * gb.w);
                *(v4u*)(KVN + (size_t)m * KVLORA + 16 * j16 + 8 * k) = o; }
            if (j16 < 8) *(v4u*)(KR + (size_t)m * 64 + 8 * j16) = krv;
        }
        f32x4 hst[31];
#pragma unroll
        for (int i = 0; i < 31; ++i) hst[i] = (f32x4){bflo(hq[i].x), bfhi(hq[i].x), bflo(hq[i].y), bfhi(hq[i].y)};
#pragma unroll
        for (int r = 0; r < 16; ++r) {
            const f32x4 s2 = hst[15 + r] + hst[14 + r];
            const f32x4 s4 = s2 + (hst[13 + r] + hst[12 + r]);
            const f32x4 s8 = s4 + ((hst[11 + r] + hst[10 + r]) + (hst[9 + r] + hst[8 + r]));
            const f32x4 s16 = s8 + (((hst[7 + r] + hst[6 + r]) + (hst[5 + r] + hst[4 + r])) + ((hst[3 + r] + hst[2 + r]) + (hst[1 + r] + hst[r])));
            const f32x4 sw = lg == 0 ? s2 : (lg == 1 ? s4 : (lg == 2 ? s8 : s16));
            const int cnt = min(s0 + r + 1, 2 << lg); const float ic = 1.0f / (float)cnt;
            const f32x4 pv = sw * ic - hst[15 + r];
            v2u o; o.x = pk2(pv.x, pv.y); o.y = pk2(pv.z, pv.w);
            *(v2u*)(PL + (size_t)(m0 + r) * POOLW + 4 * lane) = o; }
    }
}

__device__ __forceinline__ void p11_qk_norm_rope(const Frame& F, const Ptrs& P) {
    bf16* Q = (bf16*)(P.ws + WS_QRAW); const bf16* KV = (const bf16*)P.out;   const bf16* KR = (const bf16*)(P.ws + WS_KROPE);
    bf16* KB = (bf16*)(P.ws + WS_KB); bf16* VT = (bf16*)(P.ws + WS_VT);
    const float* COS = (const float*)(P.ws + WS_COS); const float* SIN = (const float*)(P.ws + WS_SIN);
    const float* qg = P.in[17]; const float* kg = P.in[18];
    const int lane = F.lane, j = lane & 15; const int gw = F.bid * NWAVES + F.wave, NGW = F.G * NWAVES;
    float gqn[8], gkn[8], gqr[4], gkr[4];
#pragma unroll
    for (int k = 0; k < 8; ++k) { gqn[k] = qg[8 * j + k] * QSCALE; gkn[k] = kg[8 * j + k]; }
    gqr[0] = qg[128 + 2 * j] * QSCALE; gqr[1] = qg[129 + 2 * j] * QSCALE; gqr[2] = qg[160 + 2 * j] * QSCALE; gqr[3] = qg[161 + 2 * j] * QSCALE;
    gkr[0] = kg[128 + 2 * j]; gkr[1] = kg[129 + 2 * j]; gkr[2] = kg[160 + 2 * j]; gkr[3] = kg[161 + 2 * j];
    constexpr int NIT = 4; const int nsteps = M * NH / 4;
    for (int it0 = gw * NIT; it0 < nsteps; it0 += NGW * NIT) {
        v4u nqv[NIT]; unsigned xav[NIT], xbv[NIT]; float c0v[NIT], c1v[NIT], s0v[NIT], s1v[NIT];
#pragma unroll
        for (int k = 0; k < NIT; ++k) { const int it = min(it0 + k, nsteps - 1); const int item = it * 4 + (lane >> 4); const int m = item / NH, h = item - m * NH;
            nqv[k] = *(const v4u*)(KV + (size_t)m * NKV + h * 256 + 8 * j);
            const bf16* r1 = KR + (size_t)m * 64 + 2 * j; xav[k] = *(const unsigned*)r1; xbv[k] = *(const unsigned*)(r1 + 32);
            c0v[k] = COS[m * 32 + 2 * j]; c1v[k] = COS[m * 32 + 2 * j + 1]; s0v[k] = SIN[m * 32 + 2 * j]; s1v[k] = SIN[m * 32 + 2 * j + 1]; }
#pragma unroll
        for (int k = 0; k < NIT; ++k) { if (it0 + k >= nsteps) break;
            const int item = (it0 + k) * 4 + (lane >> 4); const int m = item / NH, h = item - m * NH;
            const v4u nq = nqv[k];
            float v[8] = {bflo(nq.x), bfhi(nq.x), bflo(nq.y), bfhi(nq.y), bflo(nq.z), bfhi(nq.z), bflo(nq.w), bfhi(nq.w)};
            float x1a = bflo(xav[k]), x1b = bfhi(xav[k]), x2a = bflo(xbv[k]), x2b = bfhi(xbv[k]);
            float ss = (x1a * x1a + x1b * x1b) + (x2a * x2a + x2b * x2b);
#pragma unroll
            for (int e = 0; e < 8; ++e) ss += v[e] * v[e];
            ss += __shfl_xor(ss, 1); ss += __shfl_xor(ss, 2); ss += __shfl_xor(ss, 4); ss += __shfl_xor(ss, 8);
            const float rstd = 1.0f / sqrtf(ss * (1.f / QKD) + EPS);
            v4u o; o.x = pk2(v[0] * rstd * gkn[0], v[1] * rstd * gkn[1]); o.y = pk2(v[2] * rstd * gkn[2], v[3] * rstd * gkn[3]); o.z = pk2(v[4] * rstd * gkn[4], v[5] * rstd * gkn[5]); o.w = pk2(v[6] * rstd * gkn[6], v[7] * rstd * gkn[7]);
            x1a *= rstd * gkr[0]; x1b *= rstd * gkr[1]; x2a *= rstd * gkr[2]; x2b *= rstd * gkr[3];
            const unsigned o1 = pk2(x1a * c0v[k] - x2a * s0v[k], x1b * c1v[k] - x2b * s1v[k]), o2 = pk2(x2a * c0v[k] + x1a * s0v[k], x2b * c1v[k] + x1b * s1v[k]);
            bf16* dst = KB + (size_t)m * NQ + h * QKD;
            *(v4u*)(dst + 8 * j) = o; *(unsigned*)(dst + 128 + 2 * j) = o1; *(unsigned*)(dst + 160 + 2 * j) = o2; }
    }
    constexpr int TP = 136; LAS bf16* sT = (LAS bf16*)F.lds;
    const int nvu = BATCH * NH * (SEQ / 64);
    v4u vin[2];
#define P11_VLOAD(uu) do { const int sb_ = (uu) & 31, bh_ = (uu) >> 5, b_ = bh_ / NH, h_ = bh_ - b_ * NH; const size_t t0_ = (size_t)b_ * SEQ + sb_ * 64; \
        _Pragma("unroll") for (int i = 0; i < 2; ++i) { const int id = F.tid + 512 * i, r = id >> 4, c = id & 15; vin[i] = *(const v4u*)(KV + (t0_ + r) * NKV + h_ * 256 + 128 + c * 8); } } while (0)
    if (F.bid < nvu) P11_VLOAD(F.bid);
    for (int u = F.bid; u < nvu; u += F.G) {
        const int sblk = u & 31, bh = u >> 5;
#pragma unroll
        for (int i = 0; i < 2; ++i) { const int id = F.tid + 512 * i, r = id >> 4, c = id & 15; *(LAS v4u*)(sT + r * TP + c * 8) = vin[i]; }
        __syncthreads();
        if (u + F.G < nvu) P11_VLOAD(u + F.G);
#pragma unroll
        for (int i = 0; i < 2; ++i) { const int id = F.tid + 512 * i, d = id >> 3, tg = id & 7;
            unsigned short e[8];
#pragma unroll
            for (int k = 0; k < 8; ++k) e[k] = sT[(16 * (tg >> 1) + 8 * (k >> 2) + 4 * (tg & 1) + (k & 3)) * TP + d];
            v4u o; o.x = e[0] | ((unsigned)e[1] << 16); o.y = e[2] | ((unsigned)e[3] << 16); o.z = e[4] | ((unsigned)e[5] << 16); o.w = e[6] | ((unsigned)e[7] << 16);
            *(v4u*)(VT + ((size_t)bh * 128 + d) * SEQ + sblk * 64 + tg * 8) = o; }
        __syncthreads();
    }
}

template <bool FIXED> __device__ __forceinline__ void p12_attention_t(const Frame& F, const Ptrs& P, const float Cb) {
    constexpr int KP = 200, VP = 72;
    constexpr int KBUF = 64 * KP, VBUF = 128 * VP;
    LAS bf16* sK = (LAS bf16*)F.lds;
    LAS bf16* sV = (LAS bf16*)(F.lds + 2 * KBUF * 2);
    const bf16* Q = (const bf16*)(P.ws + WS_QRAW); const bf16* KB = (const bf16*)(P.ws + WS_KB); const bf16* VT = (const bf16*)(P.ws + WS_VT);
    bf16* MIX = (bf16*)(P.ws + WS_MIX);
    const int tid = F.tid, lane = F.lane, w = F.wave, ql = lane & 31, g = lane >> 5;
    const int nrounds = (768 + F.G - 1) / F.G;
    for (int rd = 0; rd < nrounds; ++rd) {
        const int idx = rd * F.G + ((rd & 1) ? (F.G - 1 - F.bid) : F.bid);
        if (idx >= 768) continue;
        const int jb = 7 - idx / 96, bh = idx % 96, b = bh / NH, h = bh - b * NH;
        const int qrow = 256 * jb + 32 * w + ql; const size_t tokq = (size_t)b * SEQ + qrow;
        bf16x8 qf[12];
        {
            v4u qr[12]; float ss = 0.f;
#pragma unroll
            for (int ds = 0; ds < 12; ++ds) { qr[ds] = *(const v4u*)(Q + tokq * NQ + h * QKD + ds * 16 + g * 8);
                const float a0 = bflo(qr[ds].x), a1 = bfhi(qr[ds].x), a2 = bflo(qr[ds].y), a3 = bfhi(qr[ds].y), a4 = bflo(qr[ds].z), a5 = bfhi(qr[ds].z), a6 = bflo(qr[ds].w), a7 = bfhi(qr[ds].w);
                ss += ((a0 * a0 + a1 * a1) + (a2 * a2 + a3 * a3)) + ((a4 * a4 + a5 * a5) + (a6 * a6 + a7 * a7)); }
            ss += __shfl_xor(ss, 32);
            const float rq = QSCALE / sqrtf(ss * (1.f / QKD) + EPS);
            const float* qg = P.in[17];
#pragma unroll
            for (int ds = 0; ds < 8; ++ds) { const f32x4 g0 = *(const f32x4*)(qg + ds * 16 + g * 8), g1 = *(const f32x4*)(qg + ds * 16 + g * 8 + 4);
                v4u w; w.x = pk2(bflo(qr[ds].x) * rq * g0.x, bfhi(qr[ds].x) * rq * g0.y); w.y = pk2(bflo(qr[ds].y) * rq * g0.z, bfhi(qr[ds].y) * rq * g0.w);
                w.z = pk2(bflo(qr[ds].z) * rq * g1.x, bfhi(qr[ds].z) * rq * g1.y); w.w = pk2(bflo(qr[ds].w) * rq * g1.z, bfhi(qr[ds].w) * rq * g1.w);
                qf[ds] = __builtin_bit_cast(bf16x8, w); }
            const float* COS = (const float*)(P.ws + WS_COS) + tokq * 32; const float* SIN = (const float*)(P.ws + WS_SIN) + tokq * 32;
#pragma unroll
            for (int dr = 0; dr < 2; ++dr) { const int i0 = dr * 16 + g * 8;
                float x1[8], x2[8], cs[8], sn[8];
                { const v4u a = qr[8 + dr], b = qr[10 + dr];
                  x1[0] = bflo(a.x); x1[1] = bfhi(a.x); x1[2] = bflo(a.y); x1[3] = bfhi(a.y); x1[4] = bflo(a.z); x1[5] = bfhi(a.z); x1[6] = bflo(a.w); x1[7] = bfhi(a.w);
                  x2[0] = bflo(b.x); x2[1] = bfhi(b.x); x2[2] = bflo(b.y); x2[3] = bfhi(b.y); x2[4] = bflo(b.z); x2[5] = bfhi(b.z); x2[6] = bflo(b.w); x2[7] = bfhi(b.w); }
#pragma unroll
                for (int e4 = 0; e4 < 2; ++e4) { const f32x4 c = *(const f32x4*)(COS + i0 + 4 * e4), sv = *(const f32x4*)(SIN + i0 + 4 * e4), ga = *(const f32x4*)(qg + 128 + i0 + 4 * e4), gb = *(const f32x4*)(qg + 160 + i0 + 4 * e4);
#pragma unroll
                    for (int k = 0; k < 4; ++k) { cs[4 * e4 + k] = c[k]; sn[4 * e4 + k] = sv[k]; x1[4 * e4 + k] *= rq * ga[k]; x2[4 * e4 + k] *= rq * gb[k]; } }
                v4u w1, w2;
                w1.x = pk2(x1[0] * cs[0] - x2[0] * sn[0], x1[1] * cs[1] - x2[1] * sn[1]); w1.y = pk2(x1[2] * cs[2] - x2[2] * sn[2], x1[3] * cs[3] - x2[3] * sn[3]);
                w1.z = pk2(x1[4] * cs[4] - x2[4] * sn[4], x1[5] * cs[5] - x2[5] * sn[5]); w1.w = pk2(x1[6] * cs[6] - x2[6] * sn[6], x1[7] * cs[7] - x2[7] * sn[7]);
                w2.x = pk2(x2[0] * cs[0] + x1[0] * sn[0], x2[1] * cs[1] + x1[1] * sn[1]); w2.y = pk2(x2[2] * cs[2] + x1[2] * sn[2], x2[3] * cs[3] + x1[3] * sn[3]);
                w2.z = pk2(x2[4] * cs[4] + x1[4] * sn[4], x2[5] * cs[5] + x1[5] * sn[5]); w2.w = pk2(x2[6] * cs[6] + x1[6] * sn[6], x2[7] * cs[7] + x1[7] * sn[7]);
                qf[8 + dr] = __builtin_bit_cast(bf16x8, w1); qf[10 + dr] = __builtin_bit_cast(bf16x8, w2); }
        }
        f32x16 o[4];
#pragma unroll
        for (int i = 0; i < 4; ++i)
#pragma unroll
            for (int r = 0; r < 16; ++r) o[i][r] = 0.f;
        float mrun = -INFINITY, lrun = 0.f;
        const int ntiles = 4 * (jb + 1), mylast = 4 * jb + (w >> 1);
        const bf16* kbase = KB + ((size_t)b * SEQ) * NQ + h * QKD; const bf16* vbase = VT + (size_t)bh * 128 * SEQ;
        v4u kr[3], vr[2];
        const bf16* kthr = kbase + (size_t)(tid >> 3) * NQ + (tid & 7) * 8; const bf16* vthr = vbase + (size_t)(tid >> 2) * SEQ + (tid & 3) * 8;
        LAS bf16* skthr = sK + (tid >> 3) * KP + (tid & 7) * 8; LAS bf16* svthr = sV + (tid >> 2) * VP + (tid & 3) * 8;
#define ATT_LOAD(t) do { _Pragma("unroll") for (int i = 0; i < 3; ++i) kr[i] = *(const v4u*)(kthr + (size_t)(t) * 64 * NQ + i * 64); \
            _Pragma("unroll") for (int i = 0; i < 2; ++i) vr[i] = *(const v4u*)(vthr + (t) * 64 + i * 32); } while (0)
#define ATT_STORE(bf) do { _Pragma("unroll") for (int i = 0; i < 3; ++i) *(LAS v4u*)(skthr + (bf) * KBUF + i * 64) = kr[i]; \
            _Pragma("unroll") for (int i = 0; i < 2; ++i) *(LAS v4u*)(svthr + (bf) * VBUF + i * 32) = vr[i]; } while (0)
        ATT_LOAD(0); ATT_STORE(0);
        __syncthreads();
        for (int t = 0; t < ntiles; ++t) {
            const int bf = t & 1;
            if (t + 1 < ntiles) ATT_LOAD(t + 1);
            if (t <= mylast) {
                f32x16 s[2];
                __builtin_amdgcn_s_setprio(1);
#pragma unroll
                for (int sub = 0; sub < 2; ++sub) {
#pragma unroll
                    for (int r = 0; r < 16; ++r) s[sub][r] = 0.f;
#pragma unroll
                    for (int ds = 0; ds < 12; ++ds) { const bf16x8 kf = *(const LAS bf16x8*)(sK + bf * KBUF + (sub * 32 + ql) * KP + ds * 16 + g * 8);
                        s[sub] = __builtin_amdgcn_mfma_f32_32x32x16_bf16(kf, qf[ds], s[sub], 0, 0, 0); }
                }
                __builtin_amdgcn_s_setprio(0);
                if (t >= 4 * jb) {
#pragma unroll
                    for (int sub = 0; sub < 2; ++sub)
#pragma unroll
                        for (int r = 0; r < 16; ++r) { const int kin = t * 64 + sub * 32 + 8 * (r >> 2) + 4 * g + (r & 3); if (kin > qrow) s[sub][r] = -INFINITY; }
                }
                bf16x8 pf[4];
                if constexpr (FIXED) {
                    __builtin_amdgcn_sched_barrier(0);
                    float rs0 = 0.f;
#pragma unroll
                    for (int kt = 0; kt < 4; ++kt) { const int sub = kt >> 1, r0 = 8 * (kt & 1); float e[8];
#pragma unroll
                        for (int k = 0; k < 8; ++k) e[k] = __builtin_amdgcn_exp2f(s[sub][r0 + k]);
                        rs0 += ((e[0] + e[1]) + (e[2] + e[3])) + ((e[4] + e[5]) + (e[6] + e[7]));
                        v4u pw; pw.x = pk2(e[0], e[1]); pw.y = pk2(e[2], e[3]); pw.z = pk2(e[4], e[5]); pw.w = pk2(e[6], e[7]);
                        pf[kt] = __builtin_bit_cast(bf16x8, pw); }
                    rs0 += __shfl_xor(rs0, 32);
                    lrun += rs0;
                    __builtin_amdgcn_sched_barrier(0);
                } else {
                float mx = s[0][0];
#pragma unroll
                for (int sub = 0; sub < 2; ++sub)
#pragma unroll
                    for (int r = 0; r < 16; ++r) mx = fmaxf(mx, s[sub][r]);
                mx = fmaxf(mx, __shfl_xor(mx, 32));
                const float mnew = fmaxf(mrun, mx); const float alpha = __builtin_amdgcn_exp2f(mrun - mnew); mrun = mnew;
                float rs = 0.f;
#pragma unroll
                for (int sub = 0; sub < 2; ++sub)
#pragma unroll
                    for (int r = 0; r < 16; ++r) { s[sub][r] = __builtin_amdgcn_exp2f(s[sub][r] - mnew); rs += s[sub][r]; }
                rs += __shfl_xor(rs, 32);
                lrun = lrun * alpha + rs;
                if (__any(alpha != 1.0f)) {
#pragma unroll
                for (int i = 0; i < 4; ++i)
#pragma unroll
                    for (int r = 0; r < 16; ++r) o[i][r] *= alpha; }
#pragma unroll
                for (int kt = 0; kt < 4; ++kt) { const int sub = kt >> 1, r0 = 8 * (kt & 1);
                    v4u pw; pw.x = pk2(s[sub][r0 + 0], s[sub][r0 + 1]); pw.y = pk2(s[sub][r0 + 2], s[sub][r0 + 3]); pw.z = pk2(s[sub][r0 + 4], s[sub][r0 + 5]); pw.w = pk2(s[sub][r0 + 6], s[sub][r0 + 7]);
                    pf[kt] = __builtin_bit_cast(bf16x8, pw); }
                }
                __builtin_amdgcn_s_setprio(1);
#pragma unroll
                for (int dsub = 0; dsub < 4; ++dsub)
#pragma unroll
                    for (int kt = 0; kt < 4; ++kt) { const bf16x8 vf = *(const LAS bf16x8*)(sV + bf * VBUF + (dsub * 32 + ql) * VP + kt * 16 + 8 * g);
                        o[dsub] = __builtin_amdgcn_mfma_f32_32x32x16_bf16(vf, pf[kt], o[dsub], 0, 0, 0); }
                __builtin_amdgcn_s_setprio(0);
            }
            if (t + 1 < ntiles) ATT_STORE(bf ^ 1);
            __syncthreads();
        }
#undef ATT_LOAD
#undef ATT_STORE
        const float il = 1.0f / lrun;
        bf16* orow = MIX + tokq * D + 256 + h * 128;
#pragma unroll
        for (int dsub = 0; dsub < 4; ++dsub)
#pragma unroll
            for (int k2 = 0; k2 < 2; ++k2) {
                v2u A, B;
                A.x = pk2(o[dsub][8 * k2 + 0] * il, o[dsub][8 * k2 + 1] * il); A.y = pk2(o[dsub][8 * k2 + 2] * il, o[dsub][8 * k2 + 3] * il);
                B.x = pk2(o[dsub][8 * k2 + 4] * il, o[dsub][8 * k2 + 5] * il); B.y = pk2(o[dsub][8 * k2 + 6] * il, o[dsub][8 * k2 + 7] * il);
                const unsigned sx = g ? A.x : B.x, sy = g ? A.y : B.y;
                const unsigned rx = (unsigned)__shfl_xor((int)sx, 32), ry = (unsigned)__shfl_xor((int)sy, 32);
                v4u ov; if (g == 0) { ov.x = A.x; ov.y = A.y; ov.z = rx; ov.w = ry; } else { ov.x = rx; ov.y = ry; ov.z = B.x; ov.w = B.y; }
                *(v4u*)(orow + dsub * 32 + 16 * k2 + 8 * g) = ov; }
    }
}
__device__ __forceinline__ void p12_attention(const Frame& F, const Ptrs& P) {
    float gqm = 0.f, gkm = 0.f;
    for (int i = F.lane; i < QKD; i += 64) { gqm = fmaxf(gqm, fabsf(P.in[17][i])); gkm = fmaxf(gkm, fabsf(P.in[18][i])); }
#pragma unroll
    for (int o = 1; o < 64; o <<= 1) { gqm = fmaxf(gqm, __shfl_xor(gqm, o)); gkm = fmaxf(gkm, __shfl_xor(gkm, o)); }
    const float Cb = __builtin_bit_cast(float, __builtin_amdgcn_readfirstlane(__builtin_bit_cast(int, (float)QKD * gqm * gkm * QSCALE * 1.06f + 0.5f)));
    if (Cb < 40.f) p12_attention_t<true>(F, P, Cb); else p12_attention_t<false>(F, P, Cb);
}

#define XB_TMO      128
#define XB_XCNT(j)  (256  + 64 * (j))
#define XB_XSUB(j)  (1280 + 64 * (j))
#define XB_XGEN(j)  (2304 + 64 * (j))
#define XB_TOP      3328
#define XB_TOPGEN   3392
#define XCD_BAR_WORDS 3456
#define XB_SPIN_CAP (1u << 18)

__device__ __forceinline__ unsigned xb_ld(unsigned* p)              { return __hip_atomic_load(p, __ATOMIC_RELAXED, __HIP_MEMORY_SCOPE_AGENT); }
__device__ __forceinline__ unsigned xb_add(unsigned* p, unsigned v) { return __hip_atomic_fetch_add(p, v, __ATOMIC_RELAXED, __HIP_MEMORY_SCOPE_AGENT); }
__device__ __forceinline__ unsigned xb_xcc_id() { return (unsigned)__builtin_amdgcn_s_getreg((3 << 11) | 20) & 0xFu; }
#define XB_SPIN(cond, bar) do { unsigned _sp = 0; while (cond) { __builtin_amdgcn_s_sleep(1); \
    if ((++_sp & 255u) == 0u) { if (xb_ld(&(bar)[XB_TMO])) break; if (_sp > XB_SPIN_CAP) { atomicAdd(&(bar)[XB_TMO], 1u); break; } } } } while (0)

struct XcdBarrier {
    unsigned* bar; unsigned x;
    volatile LAS unsigned* st;
};

__device__ __forceinline__ XcdBarrier xcd_barrier_post(unsigned* bar, volatile LAS unsigned* st) {
    XcdBarrier b; b.bar = bar; b.x = xb_xcc_id(); b.st = st;
    if (threadIdx.x == 0) (void)xb_add(&bar[XB_XCNT(b.x)], 1u);
    return b;
}
__device__ __forceinline__ void xcd_barrier_complete(unsigned* bar, unsigned x, unsigned& nloc, unsigned& nx) {
    const unsigned G = gridDim.x * gridDim.y * gridDim.z;
    unsigned sum, cnt, mine, sp = 0u;
    for (;;) {
        sum = 0u; cnt = 0u; mine = 0u;
#pragma unroll
        for (unsigned j = 0; j < 16; ++j) { const unsigned c = xb_ld(&bar[XB_XCNT(j)]); sum += c; cnt += (c > 0u) ? 1u : 0u; mine = (j == x) ? c : mine; }
        if (sum == G) break;
        __builtin_amdgcn_s_sleep(1);
        if ((++sp & 255u) == 0u) { if (xb_ld(&bar[XB_TMO])) break; if (sp > XB_SPIN_CAP) { atomicAdd(&bar[XB_TMO], 1u); break; } }
    }
    nloc = mine > 0u ? mine : 1u; nx = cnt > 0u ? cnt : 1u;
}

__device__ __forceinline__ void xcd_barrier(const XcdBarrier& b) {
    asm volatile("s_waitcnt vmcnt(0)" ::: "memory");
    __syncthreads();
    if (threadIdx.x == 0) {
        unsigned* bar = b.bar;
        __builtin_amdgcn_s_waitcnt(0);
        unsigned nloc = b.st[0], nx = b.st[1];
        if (nloc == 0u) { xcd_barrier_complete(bar, b.x, nloc, nx); b.st[0] = nloc; b.st[1] = nx; }
        const unsigned old = xb_add(&bar[XB_XSUB(b.x)], 1u);
        const unsigned gen = old / nloc;
        if (old + 1u == (gen + 1u) * nloc) {
            __builtin_amdgcn_fence(__ATOMIC_RELEASE, "agent");
            asm volatile("s_waitcnt vmcnt(0)" ::: "memory");
            const unsigned og = xb_add(&bar[XB_TOP], 1u);
            const unsigned tg = og / nx;
            if (og + 1u == (tg + 1u) * nx) xb_add(&bar[XB_TOPGEN], 1u);
            else XB_SPIN(xb_ld(&bar[XB_TOPGEN]) == tg, bar);
            __builtin_amdgcn_fence(__ATOMIC_ACQUIRE, "agent");
            xb_add(&bar[XB_XGEN(b.x)], 1u);
            asm volatile("s_waitcnt vmcnt(0)" ::: "memory");
        } else {
            XB_SPIN(xb_ld(&bar[XB_XGEN(b.x)]) == gen, bar);
            __builtin_amdgcn_fence(__ATOMIC_ACQUIRE, "agent");
            asm volatile("s_waitcnt vmcnt(0)" ::: "memory");
        }
    }
    __syncthreads();
}


__device__ __forceinline__ pg8::RowScale build_rowscale(const Frame& F, const pg8::StaticOrder& S, const float* ssq) {
    pg8::RowScale R; R.tab = (const LAS float*)(F.lds + RSTAB_OFF); R.ssq = ssq; R.pm0 = R.pm1 = R.pm2 = R.pm3 = -1;
    int nd = 0; pg8::Unit u;
    for (int i = 0; S.next(i, u); ++i) { const int pm = u.pm;
        if (pm == R.pm0 || pm == R.pm1 || pm == R.pm2 || pm == R.pm3) continue;
        if (nd == 0) R.pm0 = pm; else if (nd == 1) R.pm1 = pm; else if (nd == 2) R.pm2 = pm; else if (nd == 3) R.pm3 = pm;
        ++nd; }
    if (nd > 4) nd = 4;
    LAS float* tab = (LAS float*)(F.lds + RSTAB_OFF);
    for (int idx = F.tid; idx < nd * 256; idx += NTHR) { const int slot = idx >> 8, rl = idx & 255; const int pm = slot == 0 ? R.pm0 : (slot == 1 ? R.pm1 : (slot == 2 ? R.pm2 : R.pm3));
        const f32x4* p = (const f32x4*)(ssq + (size_t)(pm * 256 + rl) * 16); const f32x4 a = (p[0] + p[1]) + (p[2] + p[3]);
        tab[idx] = 1.0f / sqrtf(((a[0] + a[1]) + (a[2] + a[3])) * (1.f / 1024.f) + EPS); }
    __syncthreads();
    return R;
}
typedef pg8::EpiRes<true, false, true> EpiResIn; typedef pg8::EpiRes<false, false, true> EpiResMid; typedef pg8::EpiRes<false, true, false> EpiResOut;
struct Args { const float* in[23]; float* out; unsigned char* ws; int ph_lo, ph_hi; };
constexpr int NPHASE = 17;
#define GEMM_PHASE(EpiT, Aptr, Bptr, Nn, Kk, cidx, ...) do { pg8::Gemm g_{(const pg8::bf16_t*)(Aptr), (const pg8::bf16_t*)(Bptr), M, (Nn), (Kk)}; pg8::StaticOrder S_; S_.init(M, (Nn), F.G, (cidx)); \
        EpiT E_{__VA_ARGS__}; pg8::gemm_phase<EpiT, pg8::StaticOrder, true, true>(F.lds, g_, S_, E_); } while (0)

#define GEMM_PHASE_RS(EpiT, Aptr, Bptr, Nn, Kk, cidx, ...) do { pg8::Gemm g_{(const pg8::bf16_t*)(Aptr), (const pg8::bf16_t*)(Bptr), M, (Nn), (Kk)}; pg8::StaticOrder S_; S_.init(M, (Nn), F.G, (cidx)); \
        const pg8::RowScale RS_ = build_rowscale(F, S_, SSQ); EpiT E_{__VA_ARGS__, RS_}; pg8::gemm_phase<EpiT, pg8::StaticOrder, true, true>(F.lds, g_, S_, E_); } while (0)
__global__ void __launch_bounds__(NTHR, 2) trunk_fwd(Args args) {
    extern __shared__ __attribute__((aligned(16))) unsigned char lds_raw[];
    cg::grid_group grid = cg::this_grid();
    Frame F; F.lds = (LAS unsigned char*)lds_raw; F.tid = threadIdx.x; F.lane = F.tid & 63; F.wave = __builtin_amdgcn_readfirstlane(F.tid >> 6); F.G = gridDim.x; F.bid = blockIdx.x;
    Ptrs P;
#pragma unroll
    for (int i = 0; i < 23; ++i) P.in[i] = args.in[i];
    P.pos = (const int*)args.in[1]; P.out = args.out; P.ws = args.ws;
    unsigned char* ws = args.ws; float* X = args.out; bf16* XB = (bf16*)(ws + WS_XB); float* SSQ = (float*)(ws + WS_SSQ);
    const int lo = args.ph_lo, hi = args.ph_hi;
    volatile LAS unsigned* xst = (volatile LAS unsigned*)(F.lds + 131072);
    if (F.tid < 4) xst[F.tid] = 0u;
    __syncthreads();
    XcdBarrier xbar = xcd_barrier_post((unsigned*)ws, xst);
    if (hi < 0) grid.sync();
#ifndef PH_MASK
#define PH_MASK 0x1ffff
#endif
#define PH_BEGIN(k) if (((PH_MASK >> (k)) & 1) && lo <= (k) && (k) < hi) {
#ifdef PROBE_SYNC
#define PH_END(k) if ((k) + 1 < hi) { xcd_barrier(xbar); xcd_barrier(xbar); } }
#else
#define PH_END(k) if ((k) + 1 < hi) xcd_barrier(xbar); }
#endif
    PH_BEGIN(0) p0_prologue(F, P);
#ifdef PROBE_DUP0
        xcd_barrier(xbar); p0_prologue(F, P);
#endif
    PH_END(0)
    PH_BEGIN(1) GEMM_PHASE(pg8::EpiStoreBf16, ws + WS_XN, ws + WS_WIN0, EVEN_IN, D, F.bid, (pg8::bf16_t*)(ws + WS_PROJ0), EVEN_IN, 1024, EVEN_IN, nullptr, false, pg8::RowScale{}); PH_END(1)
    PH_BEGIN(2) p2_even_mixer(F, P);
#ifdef PROBE_DUP2
        xcd_barrier(xbar); p2_even_mixer(F, P);
#endif
    PH_END(2)
    PH_BEGIN(3) GEMM_PHASE(EpiResIn, ws + WS_MIX, ws + WS_WOUT0, D, D, F.bid, P.in[0], XB, D, SSQ); PH_END(3)
    PH_BEGIN(5) GEMM_PHASE_RS(pg8::EpiSwiGLU, XB, ws + WS_WGU, NGU, D, F.bid, (pg8::bf16_t*)(ws + WS_ACT), DFF); PH_END(5)
    PH_BEGIN(6) GEMM_PHASE(EpiResMid, ws + WS_ACT, ws + WS_WDN, D, DFF, F.bid, XB, XB, D, SSQ); PH_END(6)
    PH_BEGIN(8) GEMM_PHASE_RS(pg8::EpiStoreBf16, XB, ws + WS_WIN1, ODD_IN_P, D, F.bid, (pg8::bf16_t*)(ws + WS_PROJ1), ODD_IN_P, 0, ODD_IN_P, nullptr, true); PH_END(8)
    PH_BEGIN(9) p9_token_ops(F, P);
#ifdef PROBE_DUP9
        xcd_barrier(xbar); p9_token_ops(F, P);
#endif
    PH_END(9)
    PH_BEGIN(10)
        GEMM_PHASE(pg8::EpiStoreBf16, ws + WS_QN, ws + WS_WQB, NQ_P, QLORA, F.bid, (pg8::bf16_t*)(ws + WS_QRAW), NQ, 0, NQ, nullptr, false, pg8::RowScale{});
        GEMM_PHASE(pg8::EpiStoreBf16, ws + WS_KVN, ws + WS_WKVB, NKV, KVLORA, F.bid, (pg8::bf16_t*)X, NKV, 0, NKV, nullptr, false, pg8::RowScale{});
        GEMM_PHASE(pg8::EpiStoreBf16, ws + WS_POOLED, ws + WS_WPOOL, POOLW, POOLW, (F.bid + F.G / 2) % F.G, (pg8::bf16_t*)(ws + WS_MIX), D, 0, POOLW, P.in[12], false, pg8::RowScale{});
    PH_END(10)
    PH_BEGIN(11) p11_qk_norm_rope(F, P); PH_END(11)
    PH_BEGIN(12) p12_attention(F, P);
#ifdef PROBE_DUP12
        xcd_barrier(xbar); p12_attention(F, P);
#endif
    PH_END(12)
    PH_BEGIN(13) GEMM_PHASE(EpiResMid, ws + WS_MIX, ws + WS_WOUT1, D, D, F.bid, XB, XB, D, SSQ); PH_END(13)
    PH_BEGIN(15) GEMM_PHASE_RS(pg8::EpiSwiGLU, XB, (bf16*)(ws + WS_WGU) + (size_t)NGU * D, NGU, D, F.bid, (pg8::bf16_t*)(ws + WS_ACT), DFF); PH_END(15)
    PH_BEGIN(16) GEMM_PHASE(EpiResOut, ws + WS_ACT, (bf16*)(ws + WS_WDN) + (size_t)D * DFF, D, DFF, F.bid, XB, X, D, nullptr); PH_END(16)
}

#ifndef MK_MULTI
#define MK_MULTI 0
#endif
extern "C" void kernel_launch(void* const* d_in, const int* in_sizes, int n_in, void* d_out, int out_size, void* d_ws, size_t ws_size, hipStream_t stream) {
    static int grid = 0;
    if (grid == 0) {
        if (n_in != 23 || in_sizes[0] != M * D || out_size != M * D || ws_size < WS_END) { fprintf(stderr, "kernel_launch: unexpected shapes (n_in %d, in0 %d, out %d, ws %zu)\n", n_in, n_in > 0 ? in_sizes[0] : -1, out_size, ws_size); grid = -1; return; }
        int dev = 0, cus = 0, per_cu = 0;
        (void)hipGetDevice(&dev); (void)hipDeviceGetAttribute(&cus, hipDeviceAttributeMultiprocessorCount, dev);
        if (hipFuncSetAttribute((const void*)trunk_fwd, hipFuncAttributeMaxDynamicSharedMemorySize, LDS_BYTES) != hipSuccess) { fprintf(stderr, "kernel_launch: hipFuncSetAttribute failed\n"); grid = -1; return; }
        if (hipOccupancyMaxActiveBlocksPerMultiprocessor(&per_cu, (const void*)trunk_fwd, NTHR, LDS_BYTES) != hipSuccess || per_cu < 1) { fprintf(stderr, "kernel_launch: occupancy query failed (%d)\n", per_cu); per_cu = 1; }
        (void)hipGetLastError();
        grid = cus;
        if (grid > cus * per_cu) grid = cus * per_cu;
    }
    if (grid < 0) return;
    if (hipMemsetAsync(d_ws, 0, 16384, stream) != hipSuccess) { fprintf(stderr, "kernel_launch: memset of the barrier words failed\n"); return; }
    Args a{};
    for (int i = 0; i < 23; ++i) a.in[i] = (const float*)d_in[i];
    a.out = (float*)d_out; a.ws = (unsigned char*)d_ws;
#if MK_MULTI
    for (int p = 0; p < NPHASE; ++p) { a.ph_lo = p; a.ph_hi = p + 1; hipLaunchKernelGGL(trunk_fwd, dim3(grid), dim3(NTHR), LDS_BYTES, stream, a); }
#else
    a.ph_lo = 0; a.ph_hi = NPHASE;
    void* kargs[] = {&a};
    hipError_t e = hipLaunchCooperativeKernel((const void*)trunk_fwd, dim3(grid), dim3(NTHR), kargs, LDS_BYTES, stream);
    if (e != hipSuccess) fprintf(stderr, "kernel_launch: cooperative launch failed: %s (grid %d)\n", hipGetErrorString(e), grid);
#endif
}
```

```cpp
#include <hip/hip_runtime.h>
#include <hip/hip_cooperative_groups.h>
#include <cstdio>
#include <cstdint>
namespace cg = cooperative_groups;
namespace pg8 {
#define PG8_LAS __attribute__((address_space(3)))
typedef unsigned short bf16_t;
typedef short bf16x8 __attribute__((ext_vector_type(8)));
typedef float f32x4 __attribute__((ext_vector_type(4)));
typedef unsigned u32x4 __attribute__((ext_vector_type(4)));
constexpr int BM = 256, BK = 64, HALF = 128, HTB = HALF * BK * 2  , STAGE_BYTES = 8 * HTB, NXCD = 8, WGM = 8;

__host__ __device__ __forceinline__ int lds_byte(int r, int c) { const int st = (r >> 4) * 2 + (c >> 5), rr = r & 15, cc = c & 31, ob = rr * 64 + cc * 2; return st * 1024 + (ob ^ (((ob >> 9) & 1) << 5)); }
__host__ __device__ __forceinline__ void stage_rc(int b, int& R, int& C) { const int st = b / 1024, sb = b % 1024, swz = sb ^ (((sb >> 9) & 1) << 5); R = (st >> 1) * 16 + swz / 64; C = (st & 1) * 32 + (swz % 64) / 2; }
__host__ __device__ __forceinline__ int perm32(int rho) { const int n = rho >> 4, i = rho & 15; return 8 * (i >> 2) + 4 * n + (i & 3); }

struct Unit { int pm, pn; };
struct Gemm { const bf16_t* A; const bf16_t* Bt; int M, N, K; };

struct StaticOrder {
    int nM, nN, nwg, G, c;
    __host__ __device__ void init(int M, int N, int G_, int c_) { nM = M / BM; nN = N / BM; nwg = nM * nN; G = G_; c = c_; }
    __host__ __device__ bool next(int i, Unit& u) const {
        const long L = (long)i * G + c; if (L >= nwg) return false;
        int wgid = (int)L; { const int q = nwg / NXCD, r = nwg % NXCD, xcd = wgid % NXCD, off = wgid / NXCD; wgid = (xcd < r ? xcd * (q + 1) : r * (q + 1) + (xcd - r) * q) + off; }
        const int nig = WGM * nN, gid = wgid / nig, fm = gid * WGM, gsz = (nM - fm) < WGM ? (nM - fm) : WGM;
        u.pm = fm + ((wgid % nig) % gsz); u.pn = (wgid % nig) / gsz; return true;
    }
    __device__ __forceinline__ void a_ready(const Unit&) const {}
    __device__ __forceinline__ void done(const Unit&) const {}
};

__device__ __forceinline__ unsigned cvt_pk_bf16(float lo, float hi) { unsigned r; asm volatile("v_cvt_pk_bf16_f32 %0, %1, %2" : "=v"(r) : "v"(lo), "v"(hi)); return r; }
typedef float f32x2 __attribute__((ext_vector_type(2)));
__device__ __forceinline__ f32x2 gelu_pk(f32x2 v) {
    const f32x2 av = __builtin_elementwise_abs(v), d = av * 0.2316418882f + 1.0f;
    f32x2 t; t.x = __builtin_amdgcn_rcpf(d.x); t.y = __builtin_amdgcn_rcpf(d.y);
    f32x2 q = t * 0.5307027145f + (-0.7265760135f); q = q * t + 0.7107068705f; q = q * t + (-0.142248368f); q = q * t + 0.127414796f; q = q * t;
    const f32x2 s = (v * v) * (-0.72134752044f);
    f32x2 e; e.x = __builtin_amdgcn_exp2f(s.x); e.y = __builtin_amdgcn_exp2f(s.y);
    const f32x2 m = v * (q * e), r = v - m;
    f32x2 o; o.x = v.x < 0.f ? m.x : r.x; o.y = v.y < 0.f ? m.y : r.y; return o;
}

struct RowScale {
    const PG8_LAS float* tab; const float* ssq; int pm0, pm1, pm2, pm3;
    __device__ __forceinline__ float get(int pm, int rl) const {
        const int slot = pm == pm0 ? 0 : (pm == pm1 ? 1 : (pm == pm2 ? 2 : (pm == pm3 ? 3 : -1)));
        if (slot >= 0) return tab[slot * 256 + rl];
        const f32x4* p = (const f32x4*)(ssq + (size_t)(pm * BM + rl) * 16); const f32x4 a = (p[0] + p[1]) + (p[2] + p[3]);
        return 1.0f / sqrtf(((a[0] + a[1]) + (a[2] + a[3])) * (1.f / 1024.f) + 1e-6f);
    }
};
struct EpiStoreBf16 {
    static constexpr bool PERM = true, AFTER_DRAIN = false;
    bf16_t* O; int ldc; int gelu_cols; int ncols; const float* cscale; bool rowsc; RowScale rsc;
    __device__ __forceinline__ void operator()(const f32x4 (&acc)[2][2][4][2], const Unit& u, int wr, int wc, int fr, int fq) const {
        const int row0 = u.pm * BM + wr * 64 + fr; const int colt = u.pn * BM; const int col0 = colt + wc * 32 + 8 * fq;
        const bool act = colt < gelu_cols;
        f32x4 sv[2][2];
#pragma unroll
        for (int bj = 0; bj < 2; ++bj)
#pragma unroll
            for (int n = 0; n < 2; ++n) sv[bj][n] = (cscale && (col0 + bj * HALF) < ncols) ? *(const f32x4*)(cscale + col0 + bj * HALF + 4 * n) : (f32x4){1.f, 1.f, 1.f, 1.f};
#pragma unroll
        for (int ai = 0; ai < 2; ++ai)
#pragma unroll
            for (int m = 0; m < 4; ++m) { bf16_t* rowp = O + (size_t)(row0 + ai * HALF + m * 16) * ldc + col0;
                const float rs = rowsc ? rsc.get(u.pm, ai * HALF + wr * 64 + m * 16 + fr) : 1.f;
#pragma unroll
                for (int bj = 0; bj < 2; ++bj) { f32x4 v0 = acc[ai][bj][m][0], v1 = acc[ai][bj][m][1];
                    if (act) { f32x2 a = gelu_pk((f32x2){v0[0], v0[1]}), b = gelu_pk((f32x2){v0[2], v0[3]}), c = gelu_pk((f32x2){v1[0], v1[1]}), d = gelu_pk((f32x2){v1[2], v1[3]});
                        v0 = (f32x4){a.x, a.y, b.x, b.y}; v1 = (f32x4){c.x, c.y, d.x, d.y}; }
                    v0 = v0 * sv[bj][0] * rs; v1 = v1 * sv[bj][1] * rs;
                    u32x4 w; w.x = cvt_pk_bf16(v0[0], v0[1]); w.y = cvt_pk_bf16(v0[2], v0[3]); w.z = cvt_pk_bf16(v1[0], v1[1]); w.w = cvt_pk_bf16(v1[2], v1[3]);
                    if (col0 + bj * HALF < ncols) *(u32x4*)(rowp + bj * HALF) = w; } }
    }
};
template <bool BASE_F32, bool OUT_F32, bool SSQW> struct EpiRes {
    static constexpr bool PERM = true, AFTER_DRAIN = false;
    const void* base; void* out; int ldc; float* ssq;
    __device__ __forceinline__ void operator()(const f32x4 (&acc)[2][2][4][2], const Unit& u, int wr, int wc, int fr, int fq) const {
        const int row0 = u.pm * BM + wr * 64 + fr, col0 = u.pn * BM + wc * 32 + 8 * fq;
        const size_t off0 = (size_t)row0 * ldc + col0;
        f32x4 bf[2][2][2][2];
        u32x4 bh[2][2][2];
#define ER_OFF(k, mm, bj) (off0 + (size_t)(((k) >> 1) * HALF + (((k) & 1) * 2 + (mm)) * 16) * ldc + (bj) * HALF)
#define ER_LOAD(k, buf) do { _Pragma("unroll") for (int mm = 0; mm < 2; ++mm) _Pragma("unroll") for (int bj = 0; bj < 2; ++bj) { \
            if constexpr (BASE_F32) { const float* p = (const float*)base + ER_OFF(k, mm, bj); bf[buf][mm][bj][0] = *(const f32x4*)p; bf[buf][mm][bj][1] = *(const f32x4*)(p + 4); } \
            else { bh[buf][mm][bj] = *(const u32x4*)((const bf16_t*)base + ER_OFF(k, mm, bj)); } } } while (0)
#define ER_STORE(k, buf) do { _Pragma("unroll") for (int mm = 0; mm < 2; ++mm) { float sq = 0.f; _Pragma("unroll") for (int bj = 0; bj < 2; ++bj) { f32x4 v0, v1; \
            if constexpr (BASE_F32) { v0 = bf[buf][mm][bj][0]; v1 = bf[buf][mm][bj][1]; } \
            else { const u32x4 q = bh[buf][mm][bj]; v0 = (f32x4){__builtin_bit_cast(float, q.x << 16), __builtin_bit_cast(float, q.x & 0xffff0000u), __builtin_bit_cast(float, q.y << 16), __builtin_bit_cast(float, q.y & 0xffff0000u)}; \
                   v1 = (f32x4){__builtin_bit_cast(float, q.z << 16), __builtin_bit_cast(float, q.z & 0xffff0000u), __builtin_bit_cast(float, q.w << 16), __builtin_bit_cast(float, q.w & 0xffff0000u)}; } \
            v0 = v0 + acc[(k) >> 1][bj][((k) & 1) * 2 + mm][0]; v1 = v1 + acc[(k) >> 1][bj][((k) & 1) * 2 + mm][1]; \
            if constexpr (SSQW) sq += ((v0[0] * v0[0] + v0[1] * v0[1]) + (v0[2] * v0[2] + v0[3] * v0[3])) + ((v1[0] * v1[0] + v1[1] * v1[1]) + (v1[2] * v1[2] + v1[3] * v1[3])); \
            if constexpr (OUT_F32) { float* p = (float*)out + ER_OFF(k, mm, bj); *(f32x4*)p = v0; *(f32x4*)(p + 4) = v1; } \
            else { u32x4 w; w.x = cvt_pk_bf16(v0[0], v0[1]); w.y = cvt_pk_bf16(v0[2], v0[3]); w.z = cvt_pk_bf16(v1[0], v1[1]); w.w = cvt_pk_bf16(v1[2], v1[3]); *(u32x4*)((bf16_t*)out + ER_OFF(k, mm, bj)) = w; } } \
            if constexpr (SSQW) { sq += __shfl_xor(sq, 16); sq += __shfl_xor(sq, 32); if (fq == 0) ssq[(size_t)(row0 + ((k) >> 1) * HALF + (((k) & 1) * 2 + mm) * 16) * 16 + u.pn * 4 + wc] = sq; } } } while (0)
        ER_LOAD(0, 0);
        asm volatile("" ::: "memory");
        ER_LOAD(1, 1);
        asm volatile("" ::: "memory");
        ER_STORE(0, 0);
        asm volatile("" ::: "memory");
        ER_LOAD(2, 0);
        asm volatile("" ::: "memory");
        ER_STORE(1, 1);
        asm volatile("" ::: "memory");
        ER_LOAD(3, 1);
        asm volatile("" ::: "memory");
        ER_STORE(2, 0);
        asm volatile("" ::: "memory");
        ER_STORE(3, 1);
#undef ER_OFF
#undef ER_LOAD
#undef ER_STORE
    }
};
struct EpiSwiGLU {
    static constexpr bool PERM = true, AFTER_DRAIN = false;
    bf16_t* O; int ldc; RowScale rsc;
    __device__ __forceinline__ static float silu_mul(float g, float up) { return g * __builtin_amdgcn_rcpf(1.0f + __expf(-g)) * up; }
    __device__ __forceinline__ void operator()(const f32x4 (&acc)[2][2][4][2], const Unit& u, int wr, int wc, int fr, int fq) const {
        const int row0 = u.pm * BM + wr * 64 + fr, col0 = u.pn * HALF + wc * 32 + 8 * fq;
#pragma unroll
        for (int ai = 0; ai < 2; ++ai)
#pragma unroll
            for (int m = 0; m < 4; ++m) { bf16_t* rowp = O + (size_t)(row0 + ai * HALF + m * 16) * ldc + col0;
                const float rs = rsc.get(u.pm, ai * HALF + wr * 64 + m * 16 + fr);
                const f32x4 g0 = acc[ai][0][m][0] * rs, g1 = acc[ai][0][m][1] * rs, u0 = acc[ai][1][m][0] * rs, u1 = acc[ai][1][m][1] * rs;
                u32x4 w; w.x = cvt_pk_bf16(silu_mul(g0[0], u0[0]), silu_mul(g0[1], u0[1])); w.y = cvt_pk_bf16(silu_mul(g0[2], u0[2]), silu_mul(g0[3], u0[3]));
                w.z = cvt_pk_bf16(silu_mul(g1[0], u1[0]), silu_mul(g1[1], u1[1])); w.w = cvt_pk_bf16(silu_mul(g1[2], u1[2]), silu_mul(g1[3], u1[3]));
                *(u32x4*)rowp = w; }
    }
};

template <class Epi, class Sched, bool ALIGN_EPI = false, bool SP2 = false>
__device__ __forceinline__ void gemm_phase(PG8_LAS unsigned char* lds, const Gemm g, const Sched& S, const Epi& E) {
    const int tid = threadIdx.x, wid = __builtin_amdgcn_readfirstlane(tid >> 6), lane = tid & 63, wr = wid >> 2, wc = wid & 3, fr = lane & 15, fq = lane >> 4;
    const int K = g.K, nt = K / BK;
    unsigned voffA[2], voffB[2];
#pragma unroll
    for (int i = 0; i < 2; ++i) { int R, C; stage_rc(tid * 16 + i * 8192, R, C); const int Rb = Epi::PERM ? ((R & ~31) + perm32(R & 31)) : R;
        voffA[i] = (unsigned)(R * K + C) * 2u; voffB[i] = (unsigned)(Rb * K + C) * 2u; }
    const size_t kstep = (size_t)(BK * 2);
    const size_t hstep = (size_t)HALF * K * 2;
    const size_t tstep = 2 * hstep;
    const unsigned ldsw = (unsigned)wid * 1024u;
    const int aoff = lds_byte(wr * 64 + fr, fq * 8), boff = lds_byte(wc * 32 + fr, fq * 8);
#define PG8_SA(b, h) (((b) * 2 + (h)) * HTB)
#define PG8_SB(b, h) ((4 + (b) * 2 + (h)) * HTB)
#define PG8_STAGE(bufoff, gbase, voff) do { _Pragma("unroll") for (int _i = 0; _i < 2; ++_i) \
        __builtin_amdgcn_global_load_lds((const unsigned*)((const char*)(gbase) + (voff)[_i]), (PG8_LAS unsigned*)(lds + (bufoff) + ldsw + _i * 8192), 16, 0, 0); } while (0)
#define PG8_LDA(dst, b, h) do { _Pragma("unroll") for (int m = 0; m < 4; ++m) _Pragma("unroll") for (int k = 0; k < 2; ++k) dst[m][k] = *(const PG8_LAS bf16x8*)(lds + PG8_SA(b, h) + aoff + m * 2048 + k * 1024); } while (0)
#define PG8_LDB(dst, b, h) do { _Pragma("unroll") for (int n = 0; n < 2; ++n) _Pragma("unroll") for (int k = 0; k < 2; ++k) dst[n][k] = *(const PG8_LAS bf16x8*)(lds + PG8_SB(b, h) + boff + n * 2048 + k * 1024); } while (0)
#define PG8_MMA(ai, bj, At, Bt) do { __builtin_amdgcn_s_setprio(1); _Pragma("unroll") for (int m = 0; m < 4; ++m) _Pragma("unroll") for (int n = 0; n < 2; ++n) _Pragma("unroll") for (int k = 0; k < 2; ++k) \
        acc[ai][bj][m][n] = __builtin_amdgcn_mfma_f32_16x16x32_bf16(Bt[n][k], At[m][k], acc[ai][bj][m][n], 0, 0, 0); __builtin_amdgcn_s_setprio(0); } while (0)
#define PG8_WAIT_V(n) asm volatile("s_waitcnt vmcnt(" #n ")" ::: "memory")
#define PG8_WAIT_L(n) asm volatile("s_waitcnt lgkmcnt(" #n ")" ::: "memory")
#define PG8_BAR __builtin_amdgcn_s_barrier()
#define PG8_SCHED __builtin_amdgcn_sched_barrier(0)
    Unit cur, nxt; int ui = 0;
    if (!S.next(0, cur)) return;
    f32x4 acc[2][2][4][2];
#pragma unroll
    for (int a = 0; a < 2; ++a)
#pragma unroll
        for (int b = 0; b < 2; ++b)
#pragma unroll
            for (int m = 0; m < 4; ++m)
#pragma unroll
                for (int n = 0; n < 2; ++n) acc[a][b][m][n] = (f32x4){0.f, 0.f, 0.f, 0.f};
    bf16x8 At[4][2], B0[2][2], B1[2][2];
    const char* cA = (const char*)g.A + (size_t)cur.pm * tstep; const char* cB = (const char*)g.Bt + (size_t)cur.pn * tstep;
    S.a_ready(cur);
    if constexpr (SP2) {
        PG8_STAGE(PG8_SB(0, 0), cB, voffB); PG8_STAGE(PG8_SB(0, 1), cB + hstep, voffB); PG8_STAGE(PG8_SA(0, 0), cA, voffA); PG8_STAGE(PG8_SA(0, 1), cA + hstep, voffA);
        if (wr == 1) PG8_BAR;
        PG8_WAIT_V(2); PG8_BAR;
        PG8_STAGE(PG8_SB(1, 0), cB + kstep, voffB); PG8_STAGE(PG8_SA(1, 0), cA + kstep, voffA); PG8_STAGE(PG8_SB(1, 1), cB + hstep + kstep, voffB);
        PG8_WAIT_V(6); PG8_BAR;
    } else {
        PG8_STAGE(PG8_SB(0, 0), cB, voffB); PG8_STAGE(PG8_SA(0, 0), cA, voffA); PG8_STAGE(PG8_SB(0, 1), cB + hstep, voffB); PG8_STAGE(PG8_SA(0, 1), cA + hstep, voffA);
        if (wr == 1) PG8_BAR;
        PG8_WAIT_V(4); PG8_BAR;
        PG8_STAGE(PG8_SB(1, 0), cB + kstep, voffB); PG8_STAGE(PG8_SA(1, 0), cA + kstep, voffA); PG8_STAGE(PG8_SB(1, 1), cB + hstep + kstep, voffB);
        PG8_WAIT_V(6); PG8_BAR;
    }
    for (;;) {
        const bool has_next = S.next(ui + 1, nxt);
        const char* nA = has_next ? (const char*)g.A + (size_t)nxt.pm * tstep : cA; const char* nB = has_next ? (const char*)g.Bt + (size_t)nxt.pn * tstep : cB;
        for (int t = 0; t < nt; t += 2) {
            const bool last = (t == nt - 2);
            const char* a1 = cA + (size_t)(t + 1) * kstep;
            const char* a2 = last ? nA : cA + (size_t)(t + 2) * kstep; const char* b2 = last ? nB : cB + (size_t)(t + 2) * kstep;
            const char* a3 = a2 + kstep; const char* b3 = b2 + kstep;
            if (last && has_next) S.a_ready(nxt);
            if constexpr (SP2) {
            PG8_LDB(B0, 0, 0); PG8_LDB(B1, 0, 1); PG8_SCHED; PG8_LDA(At, 0, 0); PG8_STAGE(PG8_SA(1, 1), a1 + hstep, voffA);
            PG8_WAIT_V(8); PG8_WAIT_L(0); PG8_BAR; PG8_MMA(0, 0, At, B0); PG8_MMA(0, 1, At, B1); PG8_BAR; PG8_SCHED;
            PG8_LDA(At, 0, 1); PG8_STAGE(PG8_SB(0, 0), b2, voffB); PG8_STAGE(PG8_SB(0, 1), b2 + hstep, voffB); PG8_STAGE(PG8_SA(0, 0), a2, voffA);
            PG8_WAIT_V(8); PG8_WAIT_L(0); PG8_BAR; PG8_MMA(1, 0, At, B0); PG8_MMA(1, 1, At, B1); PG8_BAR; PG8_SCHED;
            PG8_LDB(B0, 1, 0); PG8_LDB(B1, 1, 1); PG8_SCHED; PG8_LDA(At, 1, 0); PG8_STAGE(PG8_SA(0, 1), a2 + hstep, voffA);
            PG8_WAIT_V(8); PG8_WAIT_L(0); PG8_BAR; PG8_MMA(0, 0, At, B0); PG8_MMA(0, 1, At, B1); PG8_BAR; PG8_SCHED;
            PG8_LDA(At, 1, 1); PG8_STAGE(PG8_SB(1, 0), b3, voffB); PG8_STAGE(PG8_SB(1, 1), b3 + hstep, voffB); PG8_STAGE(PG8_SA(1, 0), a3, voffA);
            PG8_WAIT_V(8); PG8_WAIT_L(0); PG8_BAR; PG8_MMA(1, 0, At, B0); PG8_MMA(1, 1, At, B1); PG8_BAR; PG8_SCHED;
            } else {
            PG8_LDB(B0, 0, 0); PG8_SCHED; PG8_LDA(At, 0, 0); PG8_STAGE(PG8_SA(1, 1), a1 + hstep, voffA);
            PG8_WAIT_L(8); PG8_BAR; PG8_WAIT_L(0); PG8_MMA(0, 0, At, B0); PG8_BAR; PG8_SCHED;
            PG8_LDB(B1, 0, 1); PG8_STAGE(PG8_SB(0, 0), b2, voffB);
            PG8_BAR; PG8_WAIT_L(0); PG8_MMA(0, 1, At, B1); PG8_BAR;
            PG8_LDA(At, 0, 1); PG8_STAGE(PG8_SA(0, 0), a2, voffA);
            PG8_BAR; PG8_WAIT_L(0); PG8_MMA(1, 0, At, B0); PG8_BAR; PG8_SCHED;
            PG8_STAGE(PG8_SB(0, 1), b2 + hstep, voffB);
            PG8_WAIT_V(6); PG8_BAR; PG8_MMA(1, 1, At, B1); PG8_BAR;
            PG8_LDB(B0, 1, 0); PG8_SCHED; PG8_LDA(At, 1, 0); PG8_STAGE(PG8_SA(0, 1), a2 + hstep, voffA);
            PG8_WAIT_L(8); PG8_BAR; PG8_WAIT_L(0); PG8_MMA(0, 0, At, B0); PG8_BAR; PG8_SCHED;
            PG8_LDB(B1, 1, 1); PG8_STAGE(PG8_SB(1, 0), b3, voffB);
            PG8_BAR; PG8_WAIT_L(0); PG8_MMA(0, 1, At, B1); PG8_BAR;
            PG8_LDA(At, 1, 1); PG8_STAGE(PG8_SA(1, 0), a3, voffA);
            PG8_BAR; PG8_WAIT_L(0); PG8_MMA(1, 0, At, B0); PG8_BAR; PG8_SCHED;
            PG8_STAGE(PG8_SB(1, 1), b3 + hstep, voffB);
            PG8_WAIT_V(6); PG8_BAR; PG8_MMA(1, 1, At, B1); PG8_BAR;
            }
        }
        if constexpr (ALIGN_EPI) { if (wr == 0) PG8_BAR; }
        if constexpr (!Epi::AFTER_DRAIN) { E(acc, cur, wr, wc, fr, fq); S.done(cur); }
        if (!has_next) break;
#pragma unroll
        for (int a = 0; a < 2; ++a)
#pragma unroll
            for (int b = 0; b < 2; ++b)
#pragma unroll
                for (int m = 0; m < 4; ++m)
#pragma unroll
                    for (int n = 0; n < 2; ++n) acc[a][b][m][n] = (f32x4){0.f, 0.f, 0.f, 0.f};
        cur = nxt; cA = nA; cB = nB; ++ui;
        if constexpr (ALIGN_EPI) { if (wr == 1) PG8_BAR; }
    }
    PG8_WAIT_V(0);
    if constexpr (!ALIGN_EPI) { if (wr == 0) PG8_BAR; }
    PG8_BAR;
    if constexpr (Epi::AFTER_DRAIN) { E.fused(acc, cur, wr, wc, fr, fq, lds, wid, lane); S.done(cur); }
#undef PG8_SA
#undef PG8_SB
#undef PG8_STAGE
#undef PG8_LDA
#undef PG8_LDB
#undef PG8_MMA
#undef PG8_WAIT_V
#undef PG8_WAIT_L
#undef PG8_BAR
#undef PG8_SCHED
}
}

constexpr int NWAVES = 8, NTHR = 512;
constexpr int BATCH = 16, SEQ = 2048, D = 1024, M = BATCH * SEQ;
constexpr int EVEN_IN = 2560, DFF = 2816, NGU = 2 * DFF;
constexpr int ODD_IN = 960, ODD_IN_P = 1024, POOLW = 256, QLORA = 384, KVLORA = 256;
constexpr int NH = 6, QKD = 192, NQ = NH * QKD  , NQ_P = 1280, NKV = NH * 256  ;
constexpr float EPS = 1e-6f;
constexpr float QSCALE = 0.07216878364870322f * 1.4426950408889634f;

constexpr size_t MiB = 1u << 20;
constexpr int XCD_BAR_WORDS_C = 3456;
constexpr size_t WS_WIN0 = 1 * MiB;
constexpr size_t WS_WOUT0 = WS_WIN0 + (size_t)EVEN_IN * D * 2;
constexpr size_t WS_WGU = WS_WOUT0 + (size_t)D * D * 2;
constexpr size_t WS_WDN = WS_WGU + 2 * (size_t)NGU * D * 2;
constexpr size_t WS_WIN1 = WS_WDN + 2 * (size_t)D * DFF * 2;
constexpr size_t WS_WQB = WS_WIN1 + (size_t)ODD_IN_P * D * 2;
constexpr size_t WS_WKVB = WS_WQB + (size_t)NQ_P * QLORA * 2;
constexpr size_t WS_WPOOL = WS_WKVB + (size_t)NKV * KVLORA * 2;
constexpr size_t WS_WOUT1 = WS_WPOOL + (size_t)POOLW * POOLW * 2;
constexpr size_t WS_COS = WS_WOUT1 + (size_t)D * D * 2;
constexpr size_t WS_SIN = WS_COS + (size_t)M * 32 * 4;
constexpr size_t WS_WEND = WS_SIN + (size_t)M * 32 * 4;
static_assert(XCD_BAR_WORDS_C * 4 <= 16384 && WS_WEND <= 56 * MiB, "weights region");
constexpr size_t WS_MIX = 56 * MiB;
constexpr size_t WS_XN = 120 * MiB;
constexpr size_t WS_R = 184 * MiB;
constexpr size_t WS_PROJ0 = WS_R;
constexpr size_t WS_ACT = WS_R;
constexpr size_t WS_PROJ1 = WS_R;
constexpr size_t WS_QN = WS_R + 64 * MiB;
constexpr size_t WS_KVN = WS_R + 88 * MiB;
constexpr size_t WS_POOLED = WS_R + 104 * MiB;
constexpr size_t WS_KROPE = WS_R + 120 * MiB;
constexpr size_t WS_QRAW = WS_R + 124 * MiB;
constexpr size_t WS_XB = WS_R + 196 * MiB;
constexpr size_t WS_KB = WS_XN;
constexpr size_t WS_VT = 192 * MiB;
constexpr size_t WS_SSQ = WS_XB + 64 * MiB;
constexpr size_t WS_END = WS_SSQ + 2 * MiB;
static_assert(WS_END <= 512 * MiB, "d_ws map");

constexpr int RSTAB_OFF = 131072 + 64;
constexpr int LDS_BYTES = 136192;

#define LAS __attribute__((address_space(3)))
typedef unsigned short bf16;
typedef unsigned v4u __attribute__((ext_vector_type(4)));
typedef unsigned v2u __attribute__((ext_vector_type(2)));
typedef float f32x4 __attribute__((ext_vector_type(4)));
typedef float f32x16 __attribute__((ext_vector_type(16)));
typedef short bf16x8 __attribute__((ext_vector_type(8)));
typedef short s16x4 __attribute__((ext_vector_type(4)));
#define LDS_WAIT() asm volatile("s_waitcnt lgkmcnt(0)" ::: "memory")
__device__ __forceinline__ unsigned f2bf(float f) { unsigned u = __builtin_bit_cast(unsigned, f); return (u + 0x7fffu + ((u >> 16) & 1u)) >> 16; }
__device__ __forceinline__ unsigned pk2(float lo, float hi) { return pg8::cvt_pk_bf16(lo, hi); }
__device__ __forceinline__ float bflo(unsigned w) { return __builtin_bit_cast(float, w << 16); }
__device__ __forceinline__ float bfhi(unsigned w) { return __builtin_bit_cast(float, w & 0xffff0000u); }
__device__ __forceinline__ float wave_sum(float v) {
#pragma unroll
    for (int o = 1; o < 64; o <<= 1) v += __shfl_xor(v, o);
    return v;
}

struct Frame {
    LAS unsigned char* lds;
    int tid, lane, wave, G, bid;
};

__device__ __forceinline__ void tr_item(const float* W, int ldn, int k0, int n0, bf16* WT, int ldk, int drow0, int dk0, LAS float* scr, int lane, const float* gk = nullptr) {
    f32x4 wv[8];
#pragma unroll
    for (int i = 0; i < 8; ++i) wv[i] = *(const f32x4*)(W + (size_t)(k0 + (lane >> 3) + 8 * i) * ldn + n0 + 4 * (lane & 7));
#pragma unroll
    for (int i = 0; i < 8; ++i) { const int kk = (lane >> 3) + 8 * i; const float gg = gk ? gk[k0 + kk] : 1.f; LAS float* d = scr + kk * 33 + 4 * (lane & 7);
        d[0] = wv[i].x * gg; d[1] = wv[i].y * gg; d[2] = wv[i].z * gg; d[3] = wv[i].w * gg; }
    LDS_WAIT(); asm volatile("" ::: "memory");
    const int c = lane & 7;
#pragma unroll
    for (int j = 0; j < 4; ++j) { const int n = (lane >> 3) + 8 * j; const LAS float* s = scr + (8 * c) * 33 + n;
        v4u o; o.x = pk2(s[0 * 33], s[1 * 33]); o.y = pk2(s[2 * 33], s[3 * 33]); o.z = pk2(s[4 * 33], s[5 * 33]); o.w = pk2(s[6 * 33], s[7 * 33]);
        *(v4u*)(WT + (size_t)(drow0 + n) * ldk + dk0 + 8 * c) = o; }
    LDS_WAIT(); asm volatile("" ::: "memory");
}
template <int MODE> __device__ __forceinline__ void tr_matrix(const Frame& F, const float* W, int K, int N, bf16* WT, LAS float* scr, const float* gk = nullptr) {
    const int nnb = N / 32, nit = (K / 64) * nnb; const int gw = F.bid * NWAVES + F.wave, NGW = F.G * NWAVES;
    for (int it = gw; it < nit; it += NGW) { const int kb = it / nnb, nb = it % nnb, n0 = 32 * nb;
        const int dr = MODE == 0 ? n0 : (256 * (n0 >> 7) + (n0 & 127) + (MODE == 2 ? 128 : 0));
        tr_item(W, N, 64 * kb, n0, WT, K, dr, 64 * kb, scr, F.lane, gk); }
}
template <bool IN_F32> __device__ __forceinline__ void rms_rows(const Frame& F, const void* Xv, const float* g, bf16* XN) {
    const int gw = F.bid * NWAVES + F.wave, NGW = F.G * NWAVES;
    f32x4 gv[4];
#pragma unroll
    for (int j = 0; j < 4; ++j) gv[j] = ((const f32x4*)g)[F.lane + 64 * j];
    for (int m = gw; m < M; m += NGW) {
        f32x4 v[4]; float s = 0.f;
        if constexpr (IN_F32) { const f32x4* xr = (const f32x4*)((const float*)Xv + (size_t)m * D) + F.lane;
#pragma unroll
            for (int j = 0; j < 4; ++j) v[j] = xr[64 * j]; }
        else { const v2u* xr = (const v2u*)((const bf16*)Xv + (size_t)m * D) + F.lane;
#pragma unroll
            for (int j = 0; j < 4; ++j) { const v2u q = xr[64 * j]; v[j] = (f32x4){bflo(q.x), bfhi(q.x), bflo(q.y), bfhi(q.y)}; } }
#pragma unroll
        for (int j = 0; j < 4; ++j) s += (v[j].x * v[j].x + v[j].y * v[j].y) + (v[j].z * v[j].z + v[j].w * v[j].w);
        const float rstd = 1.0f / sqrtf(wave_sum(s) * (1.f / D) + EPS);
        unsigned long long* o8 = (unsigned long long*)(XN + (size_t)m * D) + F.lane;
#pragma unroll
        for (int j = 0; j < 4; ++j) { const f32x4 y = v[j] * rstd * gv[j]; o8[64 * j] = (unsigned long long)pk2(y.x, y.y) | ((unsigned long long)pk2(y.z, y.w) << 32); }
    }
}
struct Ptrs {
    const float* in[23]; const int* pos; float* out; unsigned char* ws;
};
__device__ __forceinline__ void p0_prologue(const Frame& F, const Ptrs& P) {
    LAS float* scr = (LAS float*)(F.lds + F.wave * 16384);
    unsigned char* ws = P.ws;
    tr_matrix<0>(F, P.in[4], D, EVEN_IN, (bf16*)(ws + WS_WIN0), scr);
    tr_matrix<0>(F, P.in[9], D, D, (bf16*)(ws + WS_WOUT0), scr);
    for (int l = 0; l < 2; ++l) {
        tr_matrix<1>(F, P.in[20] + (size_t)l * D * DFF, D, DFF, (bf16*)(ws + WS_WGU) + (size_t)l * NGU * D, scr, P.in[3] + l * D);
        tr_matrix<2>(F, P.in[21] + (size_t)l * D * DFF, D, DFF, (bf16*)(ws + WS_WGU) + (size_t)l * NGU * D, scr, P.in[3] + l * D);
        tr_matrix<0>(F, P.in[22] + (size_t)l * DFF * D, DFF, D, (bf16*)(ws + WS_WDN) + (size_t)l * D * DFF, scr);
    }
    tr_matrix<0>(F, P.in[10], D, ODD_IN, (bf16*)(ws + WS_WIN1), scr, P.in[2] + D);
    tr_matrix<0>(F, P.in[14], QLORA, NQ, (bf16*)(ws + WS_WQB), scr);
    tr_matrix<0>(F, P.in[16], KVLORA, NKV, (bf16*)(ws + WS_WKVB), scr);
    tr_matrix<0>(F, P.in[19], D, D, (bf16*)(ws + WS_WOUT1), scr);
    const int gw = F.bid * NWAVES + F.wave, NGW = F.G * NWAVES;
    for (int it = gw; it < 8; it += NGW) { const int g = it >> 1, nb = it & 1;
        tr_item(P.in[11] + g * 4096, 64, 0, 32 * nb, (bf16*)(ws + WS_WPOOL), POOLW, g * 64 + 32 * nb, g * 64, scr, F.lane); }
    const int gt = F.bid * NTHR + F.tid, NGT = F.G * NTHR;
    const v4u z4 = {0u, 0u, 0u, 0u};
    { v4u* p = (v4u*)((bf16*)(ws + WS_WIN1) + (size_t)ODD_IN * D); for (int i = gt; i < (ODD_IN_P - ODD_IN) * D / 8; i += NGT) p[i] = z4; }
    { v4u* p = (v4u*)((bf16*)(ws + WS_WQB) + (size_t)NQ * QLORA); for (int i = gt; i < (NQ_P - NQ) * QLORA / 8; i += NGT) p[i] = z4; }
    { v4u* p = (v4u*)(ws + WS_WPOOL); for (int i = gt; i < POOLW * POOLW / 8; i += NGT) { const int row = i >> 5, kblk = (i & 31) >> 3; if (kblk != (row >> 6)) p[i] = z4; } }
    { float* C = (float*)(ws + WS_COS); float* S = (float*)(ws + WS_SIN);
      for (int i = gt; i < M * 32; i += NGT) { const int m = i >> 5, f = i & 31;
          const float inv = powf(10000.0f, -(float)(2 * f) / 64.0f); const float ang = (float)P.pos[m] * inv;
          const double rev = (double)ang * 0.15915494309189535; const float fr = (float)(rev - rint(rev));
          C[i] = __builtin_amdgcn_cosf(fr); S[i] = __builtin_amdgcn_sinf(fr); } }
    rms_rows<true>(F, P.in[0], P.in[2], (bf16*)(ws + WS_XN));
}

__device__ __forceinline__ void p2_even_mixer(const Frame& F, const Ptrs& P) {
    constexpr int PITCH = 136;
    LAS bf16* sW = (LAS bf16*)(F.lds);
    LAS bf16* sV = (LAS bf16*)(F.lds + 128 * PITCH * 2);
    const bf16* PROJ = (const bf16*)(P.ws + WS_PROJ0); bf16* MIX = (bf16*)(P.ws + WS_MIX);
    const float* ln_g = P.in[5]; const float* w_s = P.in[6]; const float* b_s = P.in[7]; const float* conv_w = P.in[8];
    const int tid = F.tid, lane = F.lane, w = F.wave;
    int hcur = -1;
    for (int u = F.bid; u < 1536; u += F.G) {
        if (u < 1024) {
            const int b = u >> 6, n = (u >> 2) & 15, h = u & 3; const int tok0 = b * SEQ + n * 128;
            v4u uqv[4];
            { const size_t tokl = (size_t)(tok0 + 16 * w + (lane & 15)); const int q4 = lane >> 4;
#pragma unroll
              for (int e = 0; e < 4; ++e) uqv[e] = *(const v4u*)(PROJ + tokl * EVEN_IN + h * 128 + 32 * e + 16 * (q4 & 1) + 8 * (q4 >> 1)); }
            if (h != hcur) {
                hcur = h;
                const int t = tid >> 2, s0 = (tid & 3) * 32; const f32x4* src = (const f32x4*)(w_s + ((size_t)h * 128 + t) * 128 + s0);
#pragma unroll
                for (int i = 0; i < 4; ++i) { f32x4 a = src[2 * i], c = src[2 * i + 1]; const int s = s0 + 8 * i;
                    v4u o; o.x = pk2(s + 0 <= t ? a.x : 0.f, s + 1 <= t ? a.y : 0.f); o.y = pk2(s + 2 <= t ? a.z : 0.f, s + 3 <= t ? a.w : 0.f);
                    o.z = pk2(s + 4 <= t ? c.x : 0.f, s + 5 <= t ? c.y : 0.f); o.w = pk2(s + 6 <= t ? c.z : 0.f, s + 7 <= t ? c.w : 0.f);
                    *(LAS v4u*)(sW + t * PITCH + s) = o; }
            }
            {
                const int s = tid >> 2, d0 = (tid & 3) * 32; const v4u* src = (const v4u*)(PROJ + (size_t)(tok0 + s) * EVEN_IN + 512 + h * 128 + d0);
                float v[32]; float sum = 0.f;
#pragma unroll
                for (int i = 0; i < 4; ++i) { const v4u q = src[i];
                    v[8 * i + 0] = bflo(q.x); v[8 * i + 1] = bfhi(q.x); v[8 * i + 2] = bflo(q.y); v[8 * i + 3] = bfhi(q.y);
                    v[8 * i + 4] = bflo(q.z); v[8 * i + 5] = bfhi(q.z); v[8 * i + 6] = bflo(q.w); v[8 * i + 7] = bfhi(q.w); }
#pragma unroll
                for (int i = 0; i < 32; ++i) sum += v[i];
                sum += __shfl_xor(sum, 1); sum += __shfl_xor(sum, 2);
                const float mean = sum * (1.f / 128.f); float sq = 0.f;
#pragma unroll
                for (int i = 0; i < 32; ++i) { v[i] -= mean; sq += v[i] * v[i]; }
                sq += __shfl_xor(sq, 1); sq += __shfl_xor(sq, 2);
                const float rstd = 1.0f / sqrtf(sq * (1.f / 128.f) + EPS);
                const f32x4* gp = (const f32x4*)(ln_g + h * 128 + d0);
#pragma unroll
                for (int i = 0; i < 8; ++i) { const f32x4 g = gp[i];
                    sV[(d0 + 4 * i + 0) * PITCH + s] = (bf16)f2bf(v[4 * i + 0] * rstd * g.x); sV[(d0 + 4 * i + 1) * PITCH + s] = (bf16)f2bf(v[4 * i + 1] * rstd * g.y);
                    sV[(d0 + 4 * i + 2) * PITCH + s] = (bf16)f2bf(v[4 * i + 2] * rstd * g.z); sV[(d0 + 4 * i + 3) * PITCH + s] = (bf16)f2bf(v[4 * i + 3] * rstd * g.w); }
            }
            __syncthreads();
            f32x4 acc[8];
#pragma unroll
            for (int dt = 0; dt < 8; ++dt) acc[dt] = (f32x4){0.f, 0.f, 0.f, 0.f};
            const int nk = (w >> 1) + 1;
            for (int ks = 0; ks < nk; ++ks) {
                const bf16x8 bw = *(const LAS bf16x8*)(sW + (16 * w + (lane & 15)) * PITCH + ks * 32 + (lane >> 4) * 8);
#pragma unroll
                for (int dt = 0; dt < 8; ++dt) { const bf16x8 av = *(const LAS bf16x8*)(sV + (16 * dt + (lane & 15)) * PITCH + ks * 32 + (lane >> 4) * 8);
                    acc[dt] = __builtin_amdgcn_mfma_f32_16x16x32_bf16(av, bw, acc[dt], 0, 0, 0); }
            }
            { const int t = 16 * w + (lane & 15); const float bias = b_s[h * 128 + t]; const size_t tok = (size_t)(tok0 + t);
              const int q4 = lane >> 4, odd = q4 & 1;
#pragma unroll
              for (int e = 0; e < 4; ++e) {
                  const f32x4 keep = odd ? acc[2 * e + 1] : acc[2 * e], send = odd ? acc[2 * e] : acc[2 * e + 1];
                  f32x4 recv;
#pragma unroll
                  for (int i = 0; i < 4; ++i) recv[i] = __shfl_xor(send[i], 16);
                  const f32x4 lo = odd ? recv : keep, hi = odd ? keep : recv;
                  const v4u uq = uqv[e];
                  v4u o; o.x = pk2(bflo(uq.x) * (lo[0] + bias), bfhi(uq.x) * (lo[1] + bias)); o.y = pk2(bflo(uq.y) * (lo[2] + bias), bfhi(uq.y) * (lo[3] + bias));
                  o.z = pk2(bflo(uq.z) * (hi[0] + bias), bfhi(uq.z) * (hi[1] + bias)); o.w = pk2(bflo(uq.w) * (hi[2] + bias), bfhi(uq.w) * (hi[3] + bias));
                  *(v4u*)(MIX + tok * D + h * 128 + 32 * e + 16 * odd + 8 * (q4 >> 1)) = o; } }
            __syncthreads();
        } else {
            const int cu = u - 1024, c0 = (tid & 63) * 8, tg = tid >> 6; const int tokb = cu * 64 + tg * 8; const int sb = tokb & (SEQ - 1);
            float w0[8], w1[8], w2[8];
#pragma unroll
            for (int e = 0; e < 2; ++e) { const f32x4 a = *(const f32x4*)(conv_w + c0 + 4 * e), c = *(const f32x4*)(conv_w + 512 + c0 + 4 * e), d = *(const f32x4*)(conv_w + 1024 + c0 + 4 * e);
#pragma unroll
                for (int k = 0; k < 4; ++k) { w0[4 * e + k] = a[k]; w1[4 * e + k] = c[k]; w2[4 * e + k] = d[k]; } }
            float zp2[8], zp1[8];
#pragma unroll
            for (int k = 0; k < 8; ++k) { zp2[k] = 0.f; zp1[k] = 0.f; }
#pragma unroll
            for (int i = -2; i < 8; ++i) {
                if (i < 0 && sb + i < 0) continue;
                const bf16* row = PROJ + (size_t)(tokb + i) * EVEN_IN;
                const v4u cq = *(const v4u*)(row + 1536 + c0), hq = *(const v4u*)(row + 2048 + c0);
                float z[8];
                z[0] = bflo(cq.x) * bflo(hq.x); z[1] = bfhi(cq.x) * bfhi(hq.x); z[2] = bflo(cq.y) * bflo(hq.y); z[3] = bfhi(cq.y) * bfhi(hq.y);
                z[4] = bflo(cq.z) * bflo(hq.z); z[5] = bfhi(cq.z) * bfhi(hq.z); z[6] = bflo(cq.w) * bflo(hq.w); z[7] = bfhi(cq.w) * bfhi(hq.w);
                if (i >= 0) { const v4u bq = *(const v4u*)(row + 1024 + c0);
                    float bg[8]; bg[0] = bflo(bq.x); bg[1] = bfhi(bq.x); bg[2] = bflo(bq.y); bg[3] = bfhi(bq.y); bg[4] = bflo(bq.z); bg[5] = bfhi(bq.z); bg[6] = bflo(bq.w); bg[7] = bfhi(bq.w);
                    float y[8];
#pragma unroll
                    for (int k = 0; k < 8; ++k) y[k] = bg[k] * (w0[k] * zp2[k] + w1[k] * zp1[k] + w2[k] * z[k]);
                    v4u o; o.x = pk2(y[0], y[1]); o.y = pk2(y[2], y[3]); o.z = pk2(y[4], y[5]); o.w = pk2(y[6], y[7]);
                    *(v4u*)(MIX + (size_t)(tokb + i) * D + 512 + c0) = o; }
#pragma unroll
                for (int k = 0; k < 8; ++k) { zp2[k] = zp1[k]; zp1[k] = z[k]; }
            }
        }
    }
}

__device__ __forceinline__ void p9_token_ops(const Frame& F, const Ptrs& P) {
    const bf16* PROJ = (const bf16*)(P.ws + WS_PROJ1);
    bf16* QN = (bf16*)(P.ws + WS_QN); bf16* KVN = (bf16*)(P.ws + WS_KVN); bf16* PL = (bf16*)(P.ws + WS_POOLED); bf16* KR = (bf16*)(P.ws + WS_KROPE);
    const int lane = F.lane; const int gw = F.bid * NWAVES + F.wave, NGW = F.G * NWAVES;
    const int j16 = lane & 15;
    f32x4 gqv[6], gkvv[4];
#pragma unroll
    for (int k = 0; k < 6; ++k) gqv[k] = *(const f32x4*)(P.in[13] + 24 * j16 + 4 * k);
#pragma unroll
    for (int k = 0; k < 4; ++k) gkvv[k] = *(const f32x4*)(P.in[15] + 16 * j16 + 4 * k);
    const int lg = lane >> 4;
    for (int grp = gw; grp < M / 16; grp += NGW) {
        const int m0 = grp * 16; const int s0 = m0 & (SEQ - 1);
        v2u hq[31];
#pragma unroll
        for (int i = 0; i < 31; ++i) { if (i >= 15 || s0 != 0) hq[i] = *(const v2u*)(PROJ + (size_t)(m0 + i - 15) * ODD_IN_P + 4 * lane); else hq[i] = (v2u){0u, 0u}; }
#pragma unroll 2
        for (int r4 = 0; r4 < 4; ++r4) {
            const int m = m0 + 4 * r4 + (lane >> 4); const bf16* row = PROJ + (size_t)m * ODD_IN_P;
            v4u qv[3], kvv[2];
#pragma unroll
            for (int k = 0; k < 3; ++k) qv[k] = *(const v4u*)(row + 256 + 24 * j16 + 8 * k);
#pragma unroll
            for (int k = 0; k < 2; ++k) kvv[k] = *(const v4u*)(row + 640 + 16 * j16 + 8 * k);
            v4u krv = {0u, 0u, 0u, 0u}; if (j16 < 8) krv = *(const v4u*)(row + 896 + 8 * j16);
            float sq = 0.f, sk = 0.f;
#pragma unroll
            for (int k = 0; k < 3; ++k) { const v4u q = qv[k]; const float a0 = bflo(q.x), a1 = bfhi(q.x), a2 = bflo(q.y), a3 = bfhi(q.y), a4 = bflo(q.z), a5 = bfhi(q.z), a6 = bflo(q.w), a7 = bfhi(q.w);
                sq += ((a0 * a0 + a1 * a1) + (a2 * a2 + a3 * a3)) + ((a4 * a4 + a5 * a5) + (a6 * a6 + a7 * a7)); }
#pragma unroll
            for (int k = 0; k < 2; ++k) { const v4u q = kvv[k]; const float a0 = bflo(q.x), a1 = bfhi(q.x), a2 = bflo(q.y), a3 = bfhi(q.y), a4 = bflo(q.z), a5 = bfhi(q.z), a6 = bflo(q.w), a7 = bfhi(q.w);
                sk += ((a0 * a0 + a1 * a1) + (a2 * a2 + a3 * a3)) + ((a4 * a4 + a5 * a5) + (a6 * a6 + a7 * a7)); }
#pragma unroll
            for (int o = 1; o < 16; o <<= 1) { sq += __shfl_xor(sq, o); sk += __shfl_xor(sk, o); }
            const float rq = 1.0f / sqrtf(sq * (1.f / QLORA) + EPS), rk = 1.0f / sqrtf(sk * (1.f / KVLORA) + EPS);
#pragma unroll
            for (int k = 0; k < 3; ++k) { const v4u q = qv[k]; const f32x4 ga = gqv[2 * k], gb = gqv[2 * k + 1];
                v4u o; o.x = pk2(bflo(q.x) * rq * ga.x, bfhi(q.x) * rq * ga.y); o.y = pk2(bflo(q.y) * rq * ga.z, bfhi(q.y) * rq * ga.w);
                o.z = pk2(bflo(q.z) * rq * gb.x, bfhi(q.z) * rq * gb.y); o.w = pk2(bflo(q.w) * rq * gb.z, bfhi(q.w) * rq * gb.w);
                *(v4u*)(QN + (size_t)m * QLORA + 24 * j16 + 8 * k) = o; }
#pragma unroll
            for (int k = 0; k < 2; ++k) { const v4u q = kvv[k]; const f32x4 ga = gkvv[2 * k], gb = gkvv[2 * k + 1];
                v4u o; o.x = pk2(bflo(q.x) * rk * ga.x, bfhi(q.x) * rk * ga.y); o.y = pk2(bflo(q.y) * rk * ga.z, bfhi(q.y) * rk * ga.w);
                o.z = pk2(bflo(q.z) * rk * gb.x, bfhi(q.z) * rk * gb.y); o.w = pk2(bflo(q.w) * rk * gb.z, bfhi(q.w) * rk * gb.w);
                *(v4u*)(KVN + (size_t)m * KVLORA + 16 * j16 + 8 * k) = o; }
            if (j16 < 8) *(v4u*)(KR + (size_t)m * 64 + 8 * j16) = krv;
        }
        f32x4 hst[31];
#pragma unroll
        for (int i = 0; i < 31; ++i) hst[i] = (f32x4){bflo(hq[i].x), bfhi(hq[i].x), bflo(hq[i].y), bfhi(hq[i].y)};
#pragma unroll
        for (int r = 0; r < 16; ++r) {
            const f32x4 s2 = hst[15 + r] + hst[14 + r];
            const f32x4 s4 = s2 + (hst[13 + r] + hst[12 + r]);
            const f32x4 s8 = s4 + ((hst[11 + r] + hst[10 + r]) + (hst[9 + r] + hst[8 + r]));
            const f32x4 s16 = s8 + (((hst[7 + r] + hst[6 + r]) + (hst[5 + r] + hst[4 + r])) + ((hst[3 + r] + hst[2 + r]) + (hst[1 + r] + hst[r])));
            const f32x4 sw = lg == 0 ? s2 : (lg == 1 ? s4 : (lg == 2 ? s8 : s16));
            const int cnt = min(s0 + r + 1, 2 << lg); const float ic = 1.0f / (float)cnt;
            const f32x4 pv = sw * ic - hst[15 + r];
            v2u o; o.x = pk2(pv.x, pv.y); o.y = pk2(pv.z, pv.w);
            *(v2u*)(PL + (size_t)(m0 + r) * POOLW + 4 * lane) = o; }
    }
}

__device__ __forceinline__ void p11_qk_norm_rope(const Frame& F, const Ptrs& P) {
    bf16* Q = (bf16*)(P.ws + WS_QRAW); const bf16* KV = (const bf16*)P.out;   const bf16* KR = (const bf16*)(P.ws + WS_KROPE);
    bf16* KB = (bf16*)(P.ws + WS_KB); bf16* VT = (bf16*)(P.ws + WS_VT);
    const float* COS = (const float*)(P.ws + WS_COS); const float* SIN = (const float*)(P.ws + WS_SIN);
    const float* qg = P.in[17]; const float* kg = P.in[18];
    const int lane = F.lane, j = lane & 15; const int gw = F.bid * NWAVES + F.wave, NGW = F.G * NWAVES;
    float gqn[8], gkn[8], gqr[4], gkr[4];
#pragma unroll
    for (int k = 0; k < 8; ++k) { gqn[k] = qg[8 * j + k] * QSCALE; gkn[k] = kg[8 * j + k]; }
    gqr[0] = qg[128 + 2 * j] * QSCALE; gqr[1] = qg[129 + 2 * j] * QSCALE; gqr[2] = qg[160 + 2 * j] * QSCALE; gqr[3] = qg[161 + 2 * j] * QSCALE;
    gkr[0] = kg[128 + 2 * j]; gkr[1] = kg[129 + 2 * j]; gkr[2] = kg[160 + 2 * j]; gkr[3] = kg[161 + 2 * j];
    constexpr int NIT = 4; const int nsteps = M * NH / 4;
    for (int it0 = gw * NIT; it0 < nsteps; it0 += NGW * NIT) {
        v4u nqv[NIT]; unsigned xav[NIT], xbv[NIT]; float c0v[NIT], c1v[NIT], s0v[NIT], s1v[NIT];
#pragma unroll
        for (int k = 0; k < NIT; ++k) { const int it = min(it0 + k, nsteps - 1); const int item = it * 4 + (lane >> 4); const int m = item / NH, h = item - m * NH;
            nqv[k] = *(const v4u*)(KV + (size_t)m * NKV + h * 256 + 8 * j);
            const bf16* r1 = KR + (size_t)m * 64 + 2 * j; xav[k] = *(const unsigned*)r1; xbv[k] = *(const unsigned*)(r1 + 32);
            c0v[k] = COS[m * 32 + 2 * j]; c1v[k] = COS[m * 32 + 2 * j + 1]; s0v[k] = SIN[m * 32 + 2 * j]; s1v[k] = SIN[m * 32 + 2 * j + 1]; }
#pragma unroll
        for (int k = 0; k < NIT; ++k) { if (it0 + k >= nsteps) break;
            const int item = (it0 + k) * 4 + (lane >> 4); const int m = item / NH, h = item - m * NH;
            const v4u nq = nqv[k];
            float v[8] = {bflo(nq.x), bfhi(nq.x), bflo(nq.y), bfhi(nq.y), bflo(nq.z), bfhi(nq.z), bflo(nq.w), bfhi(nq.w)};
            float x1a = bflo(xav[k]), x1b = bfhi(xav[k]), x2a = bflo(xbv[k]), x2b = bfhi(xbv[k]);
            float ss = (x1a * x1a + x1b * x1b) + (x2a * x2a + x2b * x2b);
#pragma unroll
            for (int e = 0; e < 8; ++e) ss += v[e] * v[e];
            ss += __shfl_xor(ss, 1); ss += __shfl_xor(ss, 2); ss += __shfl_xor(ss, 4); ss += __shfl_xor(ss, 8);
            const float rstd = 1.0f / sqrtf(ss * (1.f / QKD) + EPS);
            v4u o; o.x = pk2(v[0] * rstd * gkn[0], v[1] * rstd * gkn[1]); o.y = pk2(v[2] * rstd * gkn[2], v[3] * rstd * gkn[3]); o.z = pk2(v[4] * rstd * gkn[4], v[5] * rstd * gkn[5]); o.w = pk2(v[6] * rstd * gkn[6], v[7] * rstd * gkn[7]);
            x1a *= rstd * gkr[0]; x1b *= rstd * gkr[1]; x2a *= rstd * gkr[2]; x2b *= rstd * gkr[3];
            const unsigned o1 = pk2(x1a * c0v[k] - x2a * s0v[k], x1b * c1v[k] - x2b * s1v[k]), o2 = pk2(x2a * c0v[k] + x1a * s0v[k], x2b * c1v[k] + x1b * s1v[k]);
            bf16* dst = KB + (size_t)m * NQ + h * QKD;
            *(v4u*)(dst + 8 * j) = o; *(unsigned*)(dst + 128 + 2 * j) = o1; *(unsigned*)(dst + 160 + 2 * j) = o2; }
    }
    constexpr int TP = 136; LAS bf16* sT = (LAS bf16*)F.lds;
    const int nvu = BATCH * NH * (SEQ / 64);
    v4u vin[2];
#define P11_VLOAD(uu) do { const int sb_ = (uu) & 31, bh_ = (uu) >> 5, b_ = bh_ / NH, h_ = bh_ - b_ * NH; const size_t t0_ = (size_t)b_ * SEQ + sb_ * 64; \
        _Pragma("unroll") for (int i = 0; i < 2; ++i) { const int id = F.tid + 512 * i, r = id >> 4, c = id & 15; vin[i] = *(const v4u*)(KV + (t0_ + r) * NKV + h_ * 256 + 128 + c * 8); } } while (0)
    if (F.bid < nvu) P11_VLOAD(F.bid);
    for (int u = F.bid; u < nvu; u += F.G) {
        const int sblk = u & 31, bh = u >> 5;
#pragma unroll
        for (int i = 0; i < 2; ++i) { const int id = F.tid + 512 * i, r = id >> 4, c = id & 15; *(LAS v4u*)(sT + r * TP + c * 8) = vin[i]; }
        __syncthreads();
        if (u + F.G < nvu) P11_VLOAD(u + F.G);
#pragma unroll
        for (int i = 0; i < 2; ++i) { const int id = F.tid + 512 * i, d = id >> 3, tg = id & 7;
            unsigned short e[8];
#pragma unroll
            for (int k = 0; k < 8; ++k) e[k] = sT[(16 * (tg >> 1) + 8 * (k >> 2) + 4 * (tg & 1) + (k & 3)) * TP + d];
            v4u o; o.x = e[0] | ((unsigned)e[1] << 16); o.y = e[2] | ((unsigned)e[3] << 16); o.z = e[4] | ((unsigned)e[5] << 16); o.w = e[6] | ((unsigned)e[7] << 16);
            *(v4u*)(VT + ((size_t)bh * 128 + d) * SEQ + sblk * 64 + tg * 8) = o; }
        __syncthreads();
    }
}

template <bool FIXED> __device__ __forceinline__ void p12_attention_t(const Frame& F, const Ptrs& P, const float Cb) {
    constexpr int KP = 200, VP = 72;
    constexpr int KBUF = 64 * KP, VBUF = 128 * VP;
    LAS bf16* sK = (LAS bf16*)F.lds;
    LAS bf16* sV = (LAS bf16*)(F.lds + 2 * KBUF * 2);
    const bf16* Q = (const bf16*)(P.ws + WS_QRAW); const bf16* KB = (const bf16*)(P.ws + WS_KB); const bf16* VT = (const bf16*)(P.ws + WS_VT);
    bf16* MIX = (bf16*)(P.ws + WS_MIX);
    const int tid = F.tid, lane = F.lane, w = F.wave, ql = lane & 31, g = lane >> 5;
    const int nrounds = (768 + F.G - 1) / F.G;
    for (int rd = 0; rd < nrounds; ++rd) {
        const int idx = rd * F.G + ((rd & 1) ? (F.G - 1 - F.bid) : F.bid);
        if (idx >= 768) continue;
        const int jb = 7 - idx / 96, bh = idx % 96, b = bh / NH, h = bh - b * NH;
        const int qrow = 256 * jb + 32 * w + ql; const size_t tokq = (size_t)b * SEQ + qrow;
        bf16x8 qf[12];
        {
            v4u qr[12]; float ss = 0.f;
#pragma unroll
            for (int ds = 0; ds < 12; ++ds) { qr[ds] = *(const v4u*)(Q + tokq * NQ + h * QKD + ds * 16 + g * 8);
                const float a0 = bflo(qr[ds].x), a1 = bfhi(qr[ds].x), a2 = bflo(qr[ds].y), a3 = bfhi(qr[ds].y), a4 = bflo(qr[ds].z), a5 = bfhi(qr[ds].z), a6 = bflo(qr[ds].w), a7 = bfhi(qr[ds].w);
                ss += ((a0 * a0 + a1 * a1) + (a2 * a2 + a3 * a3)) + ((a4 * a4 + a5 * a5) + (a6 * a6 + a7 * a7)); }
            ss += __shfl_xor(ss, 32);
            const float rq = QSCALE / sqrtf(ss * (1.f / QKD) + EPS);
            const float* qg = P.in[17];
#pragma unroll
            for (int ds = 0; ds < 8; ++ds) { const f32x4 g0 = *(const f32x4*)(qg + ds * 16 + g * 8), g1 = *(const f32x4*)(qg + ds * 16 + g * 8 + 4);
                v4u w; w.x = pk2(bflo(qr[ds].x) * rq * g0.x, bfhi(qr[ds].x) * rq * g0.y); w.y = pk2(bflo(qr[ds].y) * rq * g0.z, bfhi(qr[ds].y) * rq * g0.w);
                w.z = pk2(bflo(qr[ds].z) * rq * g1.x, bfhi(qr[ds].z) * rq * g1.y); w.w = pk2(bflo(qr[ds].w) * rq * g1.z, bfhi(qr[ds].w) * rq * g1.w);
                qf[ds] = __builtin_bit_cast(bf16x8, w); }
            const float* COS = (const float*)(P.ws + WS_COS) + tokq * 32; const float* SIN = (const float*)(P.ws + WS_SIN) + tokq * 32;
#pragma unroll
            for (int dr = 0; dr < 2; ++dr) { const int i0 = dr * 16 + g * 8;
                float x1[8], x2[8], cs[8], sn[8];
                { const v4u a = qr[8 + dr], b = qr[10 + dr];
                  x1[0] = bflo(a.x); x1[1] = bfhi(a.x); x1[2] = bflo(a.y); x1[3] = bfhi(a.y); x1[4] = bflo(a.z); x1[5] = bfhi(a.z); x1[6] = bflo(a.w); x1[7] = bfhi(a.w);
                  x2[0] = bflo(b.x); x2[1] = bfhi(b.x); x2[2] = bflo(b.y); x2[3] = bfhi(b.y); x2[4] = bflo(b.z); x2[5] = bfhi(b.z); x2[6] = bflo(b.w); x2[7] = bfhi(b.w); }
#pragma unroll
                for (int e4 = 0; e4 < 2; ++e4) { const f32x4 c = *(const f32x4*)(COS + i0 + 4 * e4), sv = *(const f32x4*)(SIN + i0 + 4 * e4), ga = *(const f32x4*)(qg + 128 + i0 + 4 * e4), gb = *(const f32x4*)(qg + 160 + i0 + 4 * e4);
#pragma unroll
                    for (int k = 0; k < 4; ++k) { cs[4 * e4 + k] = c[k]; sn[4 * e4 + k] = sv[k]; x1[4 * e4 + k] *= rq * ga[k]; x2[4 * e4 + k] *= rq * gb[k]; } }
                v4u w1, w2;
                w1.x = pk2(x1[0] * cs[0] - x2[0] * sn[0], x1[1] * cs[1] - x2[1] * sn[1]); w1.y = pk2(x1[2] * cs[2] - x2[2] * sn[2], x1[3] * cs[3] - x2[3] * sn[3]);
                w1.z = pk2(x1[4] * cs[4] - x2[4] * sn[4], x1[5] * cs[5] - x2[5] * sn[5]); w1.w = pk2(x1[6] * cs[6] - x2[6] * sn[6], x1[7] * cs[7] - x2[7] * sn[7]);
                w2.x = pk2(x2[0] * cs[0] + x1[0] * sn[0], x2[1] * cs[1] + x1[1] * sn[1]); w2.y = pk2(x2[2] * cs[2] + x1[2] * sn[2], x2[3] * cs[3] + x1[3] * sn[3]);
                w2.z = pk2(x2[4] * cs[4] + x1[4] * sn[4], x2[5] * cs[5] + x1[5] * sn[5]); w2.w = pk2(x2[6] * cs[6] + x1[6] * sn[6], x2[7] * cs[7] + x1[7] * sn[7]);
                qf[8 + dr] = __builtin_bit_cast(bf16x8, w1); qf[10 + dr] = __builtin_bit_cast(bf16x8, w2); }
        }
        f32x16 o[4];
#pragma unroll
        for (int i = 0; i < 4; ++i)
#pragma unroll
            for (int r = 0; r < 16; ++r) o[i][r] = 0.f;
        float mrun = -INFINITY, lrun = 0.f;
        const int ntiles = 4 * (jb + 1), mylast = 4 * jb + (w >> 1);
        const bf16* kbase = KB + ((size_t)b * SEQ) * NQ + h * QKD; const bf16* vbase = VT + (size_t)bh * 128 * SEQ;
        v4u kr[3], vr[2];
        const bf16* kthr = kbase + (size_t)(tid >> 3) * NQ + (tid & 7) * 8; const bf16* vthr = vbase + (size_t)(tid >> 2) * SEQ + (tid & 3) * 8;
        LAS bf16* skthr = sK + (tid >> 3) * KP + (tid & 7) * 8; LAS bf16* svthr = sV + (tid >> 2) * VP + (tid & 3) * 8;
#define ATT_LOAD(t) do { _Pragma("unroll") for (int i = 0; i < 3; ++i) kr[i] = *(const v4u*)(kthr + (size_t)(t) * 64 * NQ + i * 64); \
            _Pragma("unroll") for (int i = 0; i < 2; ++i) vr[i] = *(const v4u*)(vthr + (t) * 64 + i * 32); } while (0)
#define ATT_STORE(bf) do { _Pragma("unroll") for (int i = 0; i < 3; ++i) *(LAS v4u*)(skthr + (bf) * KBUF + i * 64) = kr[i]; \
            _Pragma("unroll") for (int i = 0; i < 2; ++i) *(LAS v4u*)(svthr + (bf) * VBUF + i * 32) = vr[i]; } while (0)
        ATT_LOAD(0); ATT_STORE(0);
        __syncthreads();
        for (int t = 0; t < ntiles; ++t) {
            const int bf = t & 1;
            if (t + 1 < ntiles) ATT_LOAD(t + 1);
            if (t <= mylast) {
                f32x16 s[2];
                __builtin_amdgcn_s_setprio(1);
#pragma unroll
                for (int sub = 0; sub < 2; ++sub) {
#pragma unroll
                    for (int r = 0; r < 16; ++r) s[sub][r] = 0.f;
#pragma unroll
                    for (int ds = 0; ds < 12; ++ds) { const bf16x8 kf = *(const LAS bf16x8*)(sK + bf * KBUF + (sub * 32 + ql) * KP + ds * 16 + g * 8);
                        s[sub] = __builtin_amdgcn_mfma_f32_32x32x16_bf16(kf, qf[ds], s[sub], 0, 0, 0); }
                }
                __builtin_amdgcn_s_setprio(0);
                if (t >= 4 * jb) {
#pragma unroll
                    for (int sub = 0; sub < 2; ++sub)
#pragma unroll
                        for (int r = 0; r < 16; ++r) { const int kin = t * 64 + sub * 32 + 8 * (r >> 2) + 4 * g + (r & 3); if (kin > qrow) s[sub][r] = -INFINITY; }
                }
                bf16x8 pf[4];
                if constexpr (FIXED) {
                    __builtin_amdgcn_sched_barrier(0);
                    float rs0 = 0.f;
#pragma unroll
                    for (int kt = 0; kt < 4; ++kt) { const int sub = kt >> 1, r0 = 8 * (kt & 1); float e[8];
#pragma unroll
                        for (int k = 0; k < 8; ++k) e[k] = __builtin_amdgcn_exp2f(s[sub][r0 + k]);
                        rs0 += ((e[0] + e[1]) + (e[2] + e[3])) + ((e[4] + e[5]) + (e[6] + e[7]));
                        v4u pw; pw.x = pk2(e[0], e[1]); pw.y = pk2(e[2], e[3]); pw.z = pk2(e[4], e[5]); pw.w = pk2(e[6], e[7]);
                        pf[kt] = __builtin_bit_cast(bf16x8, pw); }
                    rs0 += __shfl_xor(rs0, 32);
                    lrun += rs0;
                    __builtin_amdgcn_sched_barrier(0);
                } else {
                float mx = s[0][0];
#pragma unroll
                for (int sub = 0; sub < 2; ++sub)
#pragma unroll
                    for (int r = 0; r < 16; ++r) mx = fmaxf(mx, s[sub][r]);
                mx = fmaxf(mx, __shfl_xor(mx, 32));
                const float mnew = fmaxf(mrun, mx); const float alpha = __builtin_amdgcn_exp2f(mrun - mnew); mrun = mnew;
                float rs = 0.f;
#pragma unroll
                for (int sub = 0; sub < 2; ++sub)
#pragma unroll
                    for (int r = 0; r < 16; ++r) { s[sub][r] = __builtin_amdgcn_exp2f(s[sub][r] - mnew); rs += s[sub][r]; }
                rs += __shfl_xor(rs, 32);
                lrun = lrun * alpha + rs;
                if (__any(alpha != 1.0f)) {
#pragma unroll
                for (int i = 0; i < 4; ++i)
#pragma unroll
                    for (int r = 0; r < 16; ++r) o[i][r] *= alpha; }
#pragma unroll
                for (int kt = 0; kt < 4; ++kt) { const int sub = kt >> 1, r0 = 8 * (kt & 1);
                    v4u pw; pw.x = pk2(s[sub][r0 + 0], s[sub][r0 + 1]); pw.y = pk2(s[sub][r0 + 2], s[sub][r0 + 3]); pw.z = pk2(s[sub][r0 + 4], s[sub][r0 + 5]); pw.w = pk2(s[sub][r0 + 6], s[sub][r0 + 7]);
                    pf[kt] = __builtin_bit_cast(bf16x8, pw); }
                }
                __builtin_amdgcn_s_setprio(1);
#pragma unroll
                for (int dsub = 0; dsub < 4; ++dsub)
#pragma unroll
                    for (int kt = 0; kt < 4; ++kt) { const bf16x8 vf = *(const LAS bf16x8*)(sV + bf * VBUF + (dsub * 32 + ql) * VP + kt * 16 + 8 * g);
                        o[dsub] = __builtin_amdgcn_mfma_f32_32x32x16_bf16(vf, pf[kt], o[dsub], 0, 0, 0); }
                __builtin_amdgcn_s_setprio(0);
            }
            if (t + 1 < ntiles) ATT_STORE(bf ^ 1);
            __syncthreads();
        }
#undef ATT_LOAD
#undef ATT_STORE
        const float il = 1.0f / lrun;
        bf16* orow = MIX + tokq * D + 256 + h * 128;
#pragma unroll
        for (int dsub = 0; dsub < 4; ++dsub)
#pragma unroll
            for (int k2 = 0; k2 < 2; ++k2) {
                v2u A, B;
                A.x = pk2(o[dsub][8 * k2 + 0] * il, o[dsub][8 * k2 + 1] * il); A.y = pk2(o[dsub][8 * k2 + 2] * il, o[dsub][8 * k2 + 3] * il);
                B.x = pk2(o[dsub][8 * k2 + 4] * il, o[dsub][8 * k2 + 5] * il); B.y = pk2(o[dsub][8 * k2 + 6] * il, o[dsub][8 * k2 + 7] * il);
                const unsigned sx = g ? A.x : B.x, sy = g ? A.y : B.y;
                const unsigned rx = (unsigned)__shfl_xor((int)sx, 32), ry = (unsigned)__shfl_xor((int)sy, 32);
                v4u ov; if (g == 0) { ov.x = A.x; ov.y = A.y; ov.z = rx; ov.w = ry; } else { ov.x = rx; ov.y = ry; ov.z = B.x; ov.w = B.y; }
                *(v4u*)(orow + dsub * 32 + 16 * k2 + 8 * g) = ov; }
    }
}
__device__ __forceinline__ void p12_attention(const Frame& F, const Ptrs& P) {
    float gqm = 0.f, gkm = 0.f;
    for (int i = F.lane; i < QKD; i += 64) { gqm = fmaxf(gqm, fabsf(P.in[17][i])); gkm = fmaxf(gkm, fabsf(P.in[18][i])); }
#pragma unroll
    for (int o = 1; o < 64; o <<= 1) { gqm = fmaxf(gqm, __shfl_xor(gqm, o)); gkm = fmaxf(gkm, __shfl_xor(gkm, o)); }
    const float Cb = __builtin_bit_cast(float, __builtin_amdgcn_readfirstlane(__builtin_bit_cast(int, (float)QKD * gqm * gkm * QSCALE * 1.06f + 0.5f)));
    if (Cb < 40.f) p12_attention_t<true>(F, P, Cb); else p12_attention_t<false>(F, P, Cb);
}

#define XB_TMO      128
#define XB_XCNT(j)  (256  + 64 * (j))
#define XB_XSUB(j)  (1280 + 64 * (j))
#define XB_XGEN(j)  (2304 + 64 * (j))
#define XB_TOP      3328
#define XB_TOPGEN   3392
#define XCD_BAR_WORDS 3456
#define XB_SPIN_CAP (1u << 18)

__device__ __forceinline__ unsigned xb_ld(unsigned* p)              { return __hip_atomic_load(p, __ATOMIC_RELAXED, __HIP_MEMORY_SCOPE_AGENT); }
__device__ __forceinline__ unsigned xb_add(unsigned* p, unsigned v) { return __hip_atomic_fetch_add(p, v, __ATOMIC_RELAXED, __HIP_MEMORY_SCOPE_AGENT); }
__device__ __forceinline__ unsigned xb_xcc_id() { return (unsigned)__builtin_amdgcn_s_getreg((3 << 11) | 20) & 0xFu; }
#define XB_SPIN(cond, bar) do { unsigned _sp = 0; while (cond) { __builtin_amdgcn_s_sleep(1); \
    if ((++_sp & 255u) == 0u) { if (xb_ld(&(bar)[XB_TMO])) break; if (_sp > XB_SPIN_CAP) { atomicAdd(&(bar)[XB_TMO], 1u); break; } } } } while (0)

struct XcdBarrier {
    unsigned* bar; unsigned x;
    volatile LAS unsigned* st;
};

__device__ __forceinline__ XcdBarrier xcd_barrier_post(unsigned* bar, volatile LAS unsigned* st) {
    XcdBarrier b; b.bar = bar; b.x = xb_xcc_id(); b.st = st;
    if (threadIdx.x == 0) (void)xb_add(&bar[XB_XCNT(b.x)], 1u);
    return b;
}
__device__ __forceinline__ void xcd_barrier_complete(unsigned* bar, unsigned x, unsigned& nloc, unsigned& nx) {
    const unsigned G = gridDim.x * gridDim.y * gridDim.z;
    unsigned sum, cnt, mine, sp = 0u;
    for (;;) {
        sum = 0u; cnt = 0u; mine = 0u;
#pragma unroll
        for (unsigned j = 0; j < 16; ++j) { const unsigned c = xb_ld(&bar[XB_XCNT(j)]); sum += c; cnt += (c > 0u) ? 1u : 0u; mine = (j == x) ? c : mine; }
        if (sum == G) break;
        __builtin_amdgcn_s_sleep(1);
        if ((++sp & 255u) == 0u) { if (xb_ld(&bar[XB_TMO])) break; if (sp > XB_SPIN_CAP) { atomicAdd(&bar[XB_TMO], 1u); break; } }
    }
    nloc = mine > 0u ? mine : 1u; nx = cnt > 0u ? cnt : 1u;
}

__device__ __forceinline__ void xcd_barrier(const XcdBarrier& b) {
    asm volatile("s_waitcnt vmcnt(0)" ::: "memory");
    __syncthreads();
    if (threadIdx.x == 0) {
        unsigned* bar = b.bar;
        __builtin_amdgcn_s_waitcnt(0);
        unsigned nloc = b.st[0], nx = b.st[1];
        if (nloc == 0u) { xcd_barrier_complete(bar, b.x, nloc, nx); b.st[0] = nloc; b.st[1] = nx; }
        const unsigned old = xb_add(&bar[XB_XSUB(b.x)], 1u);
        const unsigned gen = old / nloc;
        if (old + 1u == (gen + 1u) * nloc) {
            __builtin_amdgcn_fence(__ATOMIC_RELEASE, "agent");
            asm volatile("s_waitcnt vmcnt(0)" ::: "memory");
            const unsigned og = xb_add(&bar[XB_TOP], 1u);
            const unsigned tg = og / nx;
            if (og + 1u == (tg + 1u) * nx) xb_add(&bar[XB_TOPGEN], 1u);
            else XB_SPIN(xb_ld(&bar[XB_TOPGEN]) == tg, bar);
            __builtin_amdgcn_fence(__ATOMIC_ACQUIRE, "agent");
            xb_add(&bar[XB_XGEN(b.x)], 1u);
            asm volatile("s_waitcnt vmcnt(0)" ::: "memory");
        } else {
            XB_SPIN(xb_ld(&bar[XB_XGEN(b.x)]) == gen, bar);
            __builtin_amdgcn_fence(__ATOMIC_ACQUIRE, "agent");
            asm volatile("s_waitcnt vmcnt(0)" ::: "memory");
        }
    }
    __syncthreads();
}


__device__ __forceinline__ pg8::RowScale build_rowscale(const Frame& F, const pg8::StaticOrder& S, const float* ssq) {
    pg8::RowScale R; R.tab = (const LAS float*)(F.lds + RSTAB_OFF); R.ssq = ssq; R.pm0 = R.pm1 = R.pm2 = R.pm3 = -1;
    int nd = 0; pg8::Unit u;
    for (int i = 0; S.next(i, u); ++i) { const int pm = u.pm;
        if (pm == R.pm0 || pm == R.pm1 || pm == R.pm2 || pm == R.pm3) continue;
        if (nd == 0) R.pm0 = pm; else if (nd == 1) R.pm1 = pm; else if (nd == 2) R.pm2 = pm; else if (nd == 3) R.pm3 = pm;
        ++nd; }
    if (nd > 4) nd = 4;
    LAS float* tab = (LAS float*)(F.lds + RSTAB_OFF);
    for (int idx = F.tid; idx < nd * 256; idx += NTHR) { const int slot = idx >> 8, rl = idx & 255; const int pm = slot == 0 ? R.pm0 : (slot == 1 ? R.pm1 : (slot == 2 ? R.pm2 : R.pm3));
        const f32x4* p = (const f32x4*)(ssq + (size_t)(pm * 256 + rl) * 16); const f32x4 a = (p[0] + p[1]) + (p[2] + p[3]);
        tab[idx] = 1.0f / sqrtf(((a[0] + a[1]) + (a[2] + a[3])) * (1.f / 1024.f) + EPS); }
    __syncthreads();
    return R;
}
typedef pg8::EpiRes<true, false, true> EpiResIn; typedef pg8::EpiRes<false, false, true> EpiResMid; typedef pg8::EpiRes<false, true, false> EpiResOut;
struct Args { const float* in[23]; float* out; unsigned char* ws; int ph_lo, ph_hi; };
constexpr int NPHASE = 17;
#define GEMM_PHASE(EpiT, Aptr, Bptr, Nn, Kk, cidx, ...) do { pg8::Gemm g_{(const pg8::bf16_t*)(Aptr), (const pg8::bf16_t*)(Bptr), M, (Nn), (Kk)}; pg8::StaticOrder S_; S_.init(M, (Nn), F.G, (cidx)); \
        EpiT E_{__VA_ARGS__}; pg8::gemm_phase<EpiT, pg8::StaticOrder, true, true>(F.lds, g_, S_, E_); } while (0)

#define GEMM_PHASE_RS(EpiT, Aptr, Bptr, Nn, Kk, cidx, ...) do { pg8::Gemm g_{(const pg8::bf16_t*)(Aptr), (const pg8::bf16_t*)(Bptr), M, (Nn), (Kk)}; pg8::StaticOrder S_; S_.init(M, (Nn), F.G, (cidx)); \
        const pg8::RowScale RS_ = build_rowscale(F, S_, SSQ); EpiT E_{__VA_ARGS__, RS_}; pg8::gemm_phase<EpiT, pg8::StaticOrder, true, true>(F.lds, g_, S_, E_); } while (0)
__global__ void __launch_bounds__(NTHR, 2) trunk_fwd(Args args) {
    extern __shared__ __attribute__((aligned(16))) unsigned char lds_raw[];
    cg::grid_group grid = cg::this_grid();
    Frame F; F.lds = (LAS unsigned char*)lds_raw; F.tid = threadIdx.x; F.lane = F.tid & 63; F.wave = __builtin_amdgcn_readfirstlane(F.tid >> 6); F.G = gridDim.x; F.bid = blockIdx.x;
    Ptrs P;
#pragma unroll
    for (int i = 0; i < 23; ++i) P.in[i] = args.in[i];
    P.pos = (const int*)args.in[1]; P.out = args.out; P.ws = args.ws;
    unsigned char* ws = args.ws; float* X = args.out; bf16* XB = (bf16*)(ws + WS_XB); float* SSQ = (float*)(ws + WS_SSQ);
    const int lo = args.ph_lo, hi = args.ph_hi;
    volatile LAS unsigned* xst = (volatile LAS unsigned*)(F.lds + 131072);
    if (F.tid < 4) xst[F.tid] = 0u;
    __syncthreads();
    XcdBarrier xbar = xcd_barrier_post((unsigned*)ws, xst);
    if (hi < 0) grid.sync();
#ifndef PH_MASK
#define PH_MASK 0x1ffff
#endif
#define PH_BEGIN(k) if (((PH_MASK >> (k)) & 1) && lo <= (k) && (k) < hi) {
#ifdef PROBE_SYNC
#define PH_END(k) if ((k) + 1 < hi) { xcd_barrier(xbar); xcd_barrier(xbar); } }
#else
#define PH_END(k) if ((k) + 1 < hi) xcd_barrier(xbar); }
#endif
    PH_BEGIN(0) p0_prologue(F, P);
#ifdef PROBE_DUP0
        xcd_barrier(xbar); p0_prologue(F, P);
#endif
    PH_END(0)
    PH_BEGIN(1) GEMM_PHASE(pg8::EpiStoreBf16, ws + WS_XN, ws + WS_WIN0, EVEN_IN, D, F.bid, (pg8::bf16_t*)(ws + WS_PROJ0), EVEN_IN, 1024, EVEN_IN, nullptr, false, pg8::RowScale{}); PH_END(1)
    PH_BEGIN(2) p2_even_mixer(F, P);
#ifdef PROBE_DUP2
        xcd_barrier(xbar); p2_even_mixer(F, P);
#endif
    PH_END(2)
    PH_BEGIN(3) GEMM_PHASE(EpiResIn, ws + WS_MIX, ws + WS_WOUT0, D, D, F.bid, P.in[0], XB, D, SSQ); PH_END(3)
    PH_BEGIN(5) GEMM_PHASE_RS(pg8::EpiSwiGLU, XB, ws + WS_WGU, NGU, D, F.bid, (pg8::bf16_t*)(ws + WS_ACT), DFF); PH_END(5)
    PH_BEGIN(6) GEMM_PHASE(EpiResMid, ws + WS_ACT, ws + WS_WDN, D, DFF, F.bid, XB, XB, D, SSQ); PH_END(6)
    PH_BEGIN(8) GEMM_PHASE_RS(pg8::EpiStoreBf16, XB, ws + WS_WIN1, ODD_IN_P, D, F.bid, (pg8::bf16_t*)(ws + WS_PROJ1), ODD_IN_P, 0, ODD_IN_P, nullptr, true); PH_END(8)
    PH_BEGIN(9) p9_token_ops(F, P);
#ifdef PROBE_DUP9
        xcd_barrier(xbar); p9_token_ops(F, P);
#endif
    PH_END(9)
    PH_BEGIN(10)
        GEMM_PHASE(pg8::EpiStoreBf16, ws + WS_QN, ws + WS_WQB, NQ_P, QLORA, F.bid, (pg8::bf16_t*)(ws + WS_QRAW), NQ, 0, NQ, nullptr, false, pg8::RowScale{});
        GEMM_PHASE(pg8::EpiStoreBf16, ws + WS_KVN, ws + WS_WKVB, NKV, KVLORA, F.bid, (pg8::bf16_t*)X, NKV, 0, NKV, nullptr, false, pg8::RowScale{});
        GEMM_PHASE(pg8::EpiStoreBf16, ws + WS_POOLED, ws + WS_WPOOL, POOLW, POOLW, (F.bid + F.G / 2) % F.G, (pg8::bf16_t*)(ws + WS_MIX), D, 0, POOLW, P.in[12], false, pg8::RowScale{});
    PH_END(10)
    PH_BEGIN(11) p11_qk_norm_rope(F, P); PH_END(11)
    PH_BEGIN(12) p12_attention(F, P);
#ifdef PROBE_DUP12
        xcd_barrier(xbar); p12_attention(F, P);
#endif
    PH_END(12)
    PH_BEGIN(13) GEMM_PHASE(EpiResMid, ws + WS_MIX, ws + WS_WOUT1, D, D, F.bid, XB, XB, D, SSQ); PH_END(13)
    PH_BEGIN(15) GEMM_PHASE_RS(pg8::EpiSwiGLU, XB, (bf16*)(ws + WS_WGU) + (size_t)NGU * D, NGU, D, F.bid, (pg8::bf16_t*)(ws + WS_ACT), DFF); PH_END(15)
    PH_BEGIN(16) GEMM_PHASE(EpiResOut, ws + WS_ACT, (bf16*)(ws + WS_WDN) + (size_t)D * DFF, D, DFF, F.bid, XB, X, D, nullptr); PH_END(16)
}

#ifndef MK_MULTI
#define MK_MULTI 0
#endif
extern "C" void kernel_launch(void* const* d_in, const int* in_sizes, int n_in, void* d_out, int out_size, void* d_ws, size_t ws_size, hipStream_t stream) {
    static int grid = 0;
    if (grid == 0) {
        if (n_in != 23 || in_sizes[0] != M * D || out_size != M * D || ws_size < WS_END) { fprintf(stderr, "kernel_launch: unexpected shapes (n_in %d, in0 %d, out %d, ws %zu)\n", n_in, n_in > 0 ? in_sizes[0] : -1, out_size, ws_size); grid = -1; return; }
        int dev = 0, cus = 0, per_cu = 0;
        (void)hipGetDevice(&dev); (void)hipDeviceGetAttribute(&cus, hipDeviceAttributeMultiprocessorCount, dev);
        if (hipFuncSetAttribute((const void*)trunk_fwd, hipFuncAttributeMaxDynamicSharedMemorySize, LDS_BYTES) != hipSuccess) { fprintf(stderr, "kernel_launch: hipFuncSetAttribute failed\n"); grid = -1; return; }
        if (hipOccupancyMaxActiveBlocksPerMultiprocessor(&per_cu, (const void*)trunk_fwd, NTHR, LDS_BYTES) != hipSuccess || per_cu < 1) { fprintf(stderr, "kernel_launch: occupancy query failed (%d)\n", per_cu); per_cu = 1; }
        (void)hipGetLastError();
        grid = cus;
        if (grid > cus * per_cu) grid = cus * per_cu;
    }
    if (grid < 0) return;
    if (hipMemsetAsync(d_ws, 0, 16384, stream) != hipSuccess) { fprintf(stderr, "kernel_launch: memset of the barrier words failed\n"); return; }
    Args a{};
    for (int i = 0; i < 23; ++i) a.in[i] = (const float*)d_in[i];
    a.out = (float*)d_out; a.ws = (unsigned char*)d_ws;
#if MK_MULTI
    for (int p = 0; p < NPHASE; ++p) { a.ph_lo = p; a.ph_hi = p + 1; hipLaunchKernelGGL(trunk_fwd, dim3(grid), dim3(NTHR), LDS_BYTES, stream, a); }
#else
    a.ph_lo = 0; a.ph_hi = NPHASE;
    void* kargs[] = {&a};
    hipError_t e = hipLaunchCooperativeKernel((const void*)trunk_fwd, dim3(grid), dim3(NTHR), kargs, LDS_BYTES, stream);
    if (e != hipSuccess) fprintf(stderr, "kernel_launch: cooperative launch failed: %s (grid %d)\n", hipGetErrorString(e), grid);
#endif
}
```
